# Optimizing an MI355X kernel written in HIP

```python
import jax
import jax.numpy as jnp
from jax import lax
import numpy as np

D_MODEL = 1024
BATCH = 8
SEQ = 2048
DEPTH = 4

CTX_LEN = 256
GRID_W = 64
HEAD_DIM = 64
ROPE_THETA = 10000.0
EPS = 1e-6
Q_BLOCK = 128
N_BRANCH = 4
BRANCH_WIDTH = 256
A_HEADS = 4
A_KV_HEADS = 2
B_HEADS = 4
B_Q_RANK = 256
B_KV_RANK = 128
B_NOPE = 64
B_ROPE = 32
B_V = 64
C_HEADS = 4
C_KV_HEADS = 2
WINDOW = 128
WIN_BLOCK = 128
POOL_WINDOWS = (2, 4, 8, 16)
POOL_GROUPS = 4
POOL_DIM = 64
D_FF = ((8 * D_MODEL + 3 * 256 - 1) // (3 * 256)) * 256
IN_SPLITS = (A_HEADS * HEAD_DIM, A_KV_HEADS * HEAD_DIM, A_KV_HEADS * HEAD_DIM,
             B_Q_RANK, B_KV_RANK, B_ROPE,
             C_HEADS * HEAD_DIM, C_KV_HEADS * HEAD_DIM, C_KV_HEADS * HEAD_DIM,
             POOL_GROUPS * POOL_DIM, N_BRANCH * D_MODEL)
D_IN = sum(IN_SPLITS)

kernel_name = 'hybrid_prefix_diffusion_block'


def rmsnorm(x, g):
    xf = x.astype(jnp.float32)
    y = xf * lax.rsqrt(jnp.mean(xf * xf, axis=-1, keepdims=True) + EPS)
    return (y * g.astype(jnp.float32)).astype(x.dtype)


def modulate(h, shift, scale):
    return h * (1.0 + scale) + shift


def axial_rope(n_tokens, rot_dim, dtype):
    rows = n_tokens // GRID_W
    row = jnp.repeat(jnp.arange(rows), GRID_W).astype(jnp.float32)
    col = jnp.tile(jnp.arange(GRID_W), rows).astype(jnp.float32)
    n_freq = rot_dim // 4
    inv = ROPE_THETA ** (-jnp.arange(n_freq, dtype=jnp.float32) / n_freq)
    ang = jnp.concatenate([row[:, None] * inv, col[:, None] * inv], axis=-1)
    return jnp.cos(ang).astype(dtype), jnp.sin(ang).astype(dtype)


def apply_rope(x, cos, sin):
    x1, x2 = jnp.split(x, 2, axis=-1)
    return jnp.concatenate([x1 * cos - x2 * sin, x1 * sin + x2 * cos], axis=-1)


def to_heads(z, n):
    b, t, _ = z.shape
    return z.reshape(b, t, n, -1).transpose(0, 2, 1, 3)


def group_q(q, n_kv):
    b, h, t, d = q.shape
    return q.reshape(b, n_kv, h // n_kv, t, d)


def merge_heads(o):
    b, hk, g, t, d = o.shape
    return o.transpose(0, 3, 1, 2, 4).reshape(b, t, hk * g * d)


def split_in(z):
    parts, off = [], 0
    for n in IN_SPLITS:
        parts.append(z[..., off:off + n])
        off += n
    return parts


def dense_attention(q, k, v, scale):
    b, hk, g, t, d = q.shape
    nb = t // Q_BLOCK
    qb = jnp.moveaxis(q.reshape(b, hk, g, nb, Q_BLOCK, d), 3, 0)

    def one_block(qi):
        s = jnp.einsum('bkgqd,bktd->bkgqt', qi, k, preferred_element_type=jnp.float32) * scale
        p = jax.nn.softmax(s, axis=-1).astype(v.dtype)
        return jnp.einsum('bkgqt,bktv->bkgqv', p, v)

    o = lax.map(one_block, qb)
    return jnp.moveaxis(o, 0, 3).reshape(b, hk, g, t, v.shape[-1])


def sink_attention(q, k, v, sink, scale):
    b, hk, g, t, d = q.shape
    s = jnp.einsum('bkgqd,bktd->bkgqt', q, k, preferred_element_type=jnp.float32) * scale
    s_sink = jnp.broadcast_to(sink.astype(jnp.float32).reshape(1, hk, g, 1, 1), s.shape[:-1] + (1,))
    p = jax.nn.softmax(jnp.concatenate([s, s_sink], axis=-1), axis=-1)[..., :-1].astype(v.dtype)
    return jnp.einsum('bkgqt,bktd->bkgqd', p, v)


def window_sink_attention(q, k, v, kc, vc, sink, scale):
    b, hk, g, t, d = q.shape
    w = WIN_BLOCK
    nb = t // w

    def band(z):
        zp = jnp.pad(z, ((0, 0), (0, 0), (w, w), (0, 0))).reshape(b, hk, nb + 2, w, z.shape[-1])
        return jnp.concatenate([zp[:, :, :-2], zp[:, :, 1:-1], zp[:, :, 2:]], axis=3)

    kb, vb = band(k), band(v)
    qb = q.reshape(b, hk, g, nb, w, d)
    s_loc = jnp.einsum('bkgnqd,bkntd->bkgnqt', qb, kb, preferred_element_type=jnp.float32) * scale
    qpos = jnp.arange(nb)[:, None] * w + jnp.arange(w)[None, :]
    kpos = (jnp.arange(nb)[:, None] - 1) * w + jnp.arange(3 * w)[None, :]
    rel = kpos[:, None, :] - qpos[:, :, None]
    valid = (jnp.abs(rel) <= WINDOW) & (kpos[:, None, :] >= 0) & (kpos[:, None, :] < t)
    s_loc = jnp.where(valid, s_loc, -1e30)
    s_ctx = jnp.einsum('bkgnqd,bkcd->bkgnqc', qb, kc, preferred_element_type=jnp.float32) * scale
    s_sink = jnp.broadcast_to(sink.astype(jnp.float32).reshape(1, hk, g, 1, 1, 1), s_loc.shape[:-1] + (1,))
    p = jax.nn.softmax(jnp.concatenate([s_loc, s_ctx, s_sink], axis=-1), axis=-1)
    p_loc = p[..., :3 * w].astype(v.dtype)
    p_ctx = p[..., 3 * w:3 * w + kc.shape[2]].astype(v.dtype)
    o = (jnp.einsum('bkgnqt,bkntd->bkgnqd', p_loc, vb)
         + jnp.einsum('bkgnqc,bkcd->bkgnqd', p_ctx, vc))
    return o.reshape(b, hk, g, t, d)


def multiscale_pool(u, w_pool, pool_scale):
    b, t, _ = u.shape
    ug = u.reshape(b, t, POOL_GROUPS, POOL_DIM)
    cs = jnp.cumsum(jnp.pad(ug.astype(jnp.float32), ((0, 0), (1, 0), (0, 0), (0, 0))), axis=1)
    pos = jnp.arange(t)
    means = []
    for gi, win in enumerate(POOL_WINDOWS):
        lo = win // 2
        hi = win - lo - 1
        start = jnp.clip(pos - lo, 0, t)
        end = jnp.clip(pos + hi + 1, 0, t)
        csg = cs[:, :, gi]
        means.append((csg[:, end] - csg[:, start]) / (end - start).astype(jnp.float32)[None, :, None])
    pooled = jnp.stack(means, axis=2).astype(u.dtype)
    mixed = jnp.einsum('btgc,gcd->btgd', pooled - ug, w_pool).reshape(b, t, -1)
    return mixed * pool_scale


def stream_heads(z, rope64, rope32, a_qn_g, a_kn_g, b_qa_g, b_kva_g, b_w_qb, b_w_kvb):
    qa, ka, va, qba, kvba, kbr, qc, kc, vc, u, gl = split_in(z)
    qa = rmsnorm(to_heads(qa, A_HEADS), a_qn_g)
    ka = rmsnorm(to_heads(ka, A_KV_HEADS), a_kn_g)
    va = to_heads(va, A_KV_HEADS)
    qb = to_heads(rmsnorm(qba, b_qa_g) @ b_w_qb, B_HEADS)
    qb_nope, qb_rope = qb[..., :B_NOPE], qb[..., B_NOPE:]
    kvb = to_heads(rmsnorm(kvba, b_kva_g) @ b_w_kvb, B_HEADS)
    kb_nope, vb = kvb[..., :B_NOPE], kvb[..., B_NOPE:]
    kbr = kbr[:, None]
    qc = to_heads(qc, C_HEADS)
    kc = to_heads(kc, C_KV_HEADS)
    vc = to_heads(vc, C_KV_HEADS)
    if rope64 is not None:
        qa, ka, qc, kc = [apply_rope(a, *rope64) for a in (qa, ka, qc, kc)]
        qb_rope = apply_rope(qb_rope, *rope32)
        kbr = apply_rope(kbr, *rope32)
    qb = jnp.concatenate([qb_nope, qb_rope], axis=-1)
    kb = jnp.concatenate([kb_nope, jnp.broadcast_to(kbr, kb_nope.shape[:-1] + (B_ROPE,))], axis=-1)
    return (group_q(qa, A_KV_HEADS), ka, va, qb[:, :, None], kb, vb,
            group_q(qc, C_KV_HEADS), kc, vc, u, gl)


def merge_branches(outs, gl, w_branch, w_out):
    o = jnp.stack(outs, axis=2)
    proj = jnp.einsum('btkc,kcd->btkd', o, w_branch)
    gates = jax.nn.sigmoid(gl.reshape(gl.shape[:-1] + (N_BRANCH, D_MODEL)))
    return jnp.sum(gates * proj, axis=2) @ w_out


def mixer_layer(hx, hc, rope64, rope32, w_in, a_qn_g, a_kn_g, b_qa_g, b_kva_g, b_w_qb, b_w_kvb,
                c_sink, d_w_pool, d_scale, w_branch, w_out, with_ctx):
    sx = stream_heads(hx @ w_in, rope64, rope32, a_qn_g, a_kn_g, b_qa_g, b_kva_g, b_w_qb, b_w_kvb)
    sc = stream_heads(hc @ w_in, None, None, a_qn_g, a_kn_g, b_qa_g, b_kva_g, b_w_qb, b_w_kvb)
    qa_x, ka_x, va_x, qb_x, kb_x, vb_x, qc_x, kc_x, vc_x, u_x, gl_x = sx
    qa_c, ka_c, va_c, qb_c, kb_c, vb_c, qc_c, kc_c, vc_c, u_c, gl_c = sc
    sc_a = HEAD_DIM ** -0.5
    sc_b = (B_NOPE + B_ROPE) ** -0.5
    cat = lambda ctx_part, lat_part: jnp.concatenate([ctx_part, lat_part], axis=2)
    o_a = dense_attention(qa_x, cat(ka_c, ka_x), cat(va_c, va_x), sc_a)
    o_b = dense_attention(qb_x, cat(kb_c, kb_x), cat(vb_c, vb_x), sc_b)
    o_c = window_sink_attention(qc_x, kc_x, vc_x, kc_c, vc_c, c_sink, sc_a)
    o_d = multiscale_pool(u_x, d_w_pool, d_scale)
    yx = merge_branches([merge_heads(o_a), merge_heads(o_b), merge_heads(o_c), o_d], gl_x, w_branch, w_out)
    if not with_ctx:
        return yx, None
    oc_a = dense_attention(qa_c, ka_c, va_c, sc_a)
    oc_b = dense_attention(qb_c, kb_c, vb_c, sc_b)
    oc_c = sink_attention(qc_c, kc_c, vc_c, c_sink, sc_a)
    oc_d = multiscale_pool(u_c, d_w_pool, d_scale)
    yc = merge_branches([merge_heads(oc_a), merge_heads(oc_b), merge_heads(oc_c), oc_d], gl_c, w_branch, w_out)
    return yx, yc


def swiglu(h, w1, w3, w2):
    return (jax.nn.silu(h @ w1) * (h @ w3)) @ w2


def setup_inputs(seed: int = 0) -> dict:
    key = jax.random.key(seed)
    ks = iter(jax.random.split(key, 32))
    f32 = jnp.float32
    L = DEPTH

    def nrm(shape, fan_in):
        return jax.random.normal(next(ks), shape, f32) * fan_in ** -0.5

    def gain(shape, noise=0.02):
        return 1.0 + noise * jax.random.normal(next(ks), shape, f32)

    return {
        'x': jax.random.normal(next(ks), (BATCH, SEQ, D_MODEL), f32),
        'c': jax.random.normal(next(ks), (BATCH, D_MODEL), f32),
        'ctx': jax.random.normal(next(ks), (BATCH, CTX_LEN, D_MODEL), f32),
        'c_ctx': jax.random.normal(next(ks), (D_MODEL,), f32),
        'ada_w': nrm((L, D_MODEL, 6 * D_MODEL), D_MODEL),
        'ada_b': 0.02 * jax.random.normal(next(ks), (L, 6 * D_MODEL), f32),
        'mix_pre_g': gain((L, D_MODEL)),
        'mix_post_g': gain((L, D_MODEL)),
        'ffn_pre_g': gain((L, D_MODEL)),
        'ffn_post_g': gain((L, D_MODEL)),
        'w_in': nrm((L, D_MODEL, D_IN), D_MODEL),
        'a_qn_g': gain((L, HEAD_DIM)),
        'a_kn_g': gain((L, HEAD_DIM)),
        'b_qa_g': gain((L, B_Q_RANK)),
        'b_kva_g': gain((L, B_KV_RANK)),
        'b_w_qb': nrm((L, B_Q_RANK, B_HEADS * (B_NOPE + B_ROPE)), B_Q_RANK),
        'b_w_kvb': nrm((L, B_KV_RANK, B_HEADS * (B_NOPE + B_V)), B_KV_RANK),
        'c_sink': jax.random.normal(next(ks), (L, C_HEADS), f32),
        'd_w_pool': nrm((L, POOL_GROUPS, POOL_DIM, POOL_DIM), POOL_DIM),
        'd_scale': gain((L, POOL_GROUPS * POOL_DIM), 0.1),
        'w_branch': nrm((L, N_BRANCH, BRANCH_WIDTH, D_MODEL), BRANCH_WIDTH),
        'w_out': nrm((L, D_MODEL, D_MODEL), D_MODEL),
        'w_ffn1': nrm((L, D_MODEL, D_FF), D_MODEL),
        'w_ffn3': nrm((L, D_MODEL, D_FF), D_MODEL),
        'w_ffn2': nrm((L, D_FF, D_MODEL), D_FF),
    }


def reference(x, c, ctx, c_ctx, ada_w, ada_b, mix_pre_g, mix_post_g, ffn_pre_g, ffn_post_g,
              w_in, a_qn_g, a_kn_g, b_qa_g, b_kva_g, b_w_qb, b_w_kvb, c_sink, d_w_pool, d_scale,
              w_branch, w_out, w_ffn1, w_ffn3, w_ffn2):
    n_tok = x.shape[1]
    rope64 = axial_rope(n_tok, HEAD_DIM, x.dtype)
    rope32 = axial_rope(n_tok, B_ROPE, x.dtype)
    xc = ctx
    for l in range(DEPTH):
        with_ctx = l < DEPTH - 1
        mod_x = (jax.nn.silu(c) @ ada_w[l] + ada_b[l])[:, None, :]
        mod_c = (jax.nn.silu(c_ctx) @ ada_w[l] + ada_b[l])[None, None, :]
        shx1, scx1, gx1, shx2, scx2, gx2 = jnp.split(mod_x, 6, axis=-1)
        shc1, scc1, gc1, shc2, scc2, gc2 = jnp.split(mod_c, 6, axis=-1)
        hx = modulate(rmsnorm(x, mix_pre_g[l]), shx1, scx1)
        hc = modulate(rmsnorm(xc, mix_pre_g[l]), shc1, scc1)
        yx, yc = mixer_layer(hx, hc, rope64, rope32, w_in[l], a_qn_g[l], a_kn_g[l], b_qa_g[l], b_kva_g[l],
                             b_w_qb[l], b_w_kvb[l], c_sink[l], d_w_pool[l], d_scale[l], w_branch[l], w_out[l],
                             with_ctx)
        x = x + gx1 * rmsnorm(yx, mix_post_g[l])
        fx = swiglu(modulate(rmsnorm(x, ffn_pre_g[l]), shx2, scx2), w_ffn1[l], w_ffn3[l], w_ffn2[l])
        x = x + gx2 * rmsnorm(fx, ffn_post_g[l])
        if with_ctx:
            xc = xc + gc1 * rmsnorm(yc, mix_post_g[l])
            fc = swiglu(modulate(rmsnorm(xc, ffn_pre_g[l]), shc2, scc2), w_ffn1[l], w_ffn3[l], w_ffn2[l])
            xc = xc + gc2 * rmsnorm(fc, ffn_post_g[l])
    return x
```

```cpp
#include <hip/hip_runtime.h>
#include <hip/hip_cooperative_groups.h>
#include <cstdio>
#include <cstdint>
#include <type_traits>
namespace cg = cooperative_groups;

#ifndef MEGA
#define MEGA 1
#endif

#define LAS __attribute__((address_space(3)))
typedef unsigned short bf16_t;
typedef short bf16x8 __attribute__((ext_vector_type(8)));
typedef short s16x4 __attribute__((ext_vector_type(4)));
typedef float f32x4 __attribute__((ext_vector_type(4)));
typedef float f32x16 __attribute__((ext_vector_type(16)));
typedef unsigned u32x4 __attribute__((ext_vector_type(4)));
typedef unsigned u32x2 __attribute__((ext_vector_type(2)));

constexpr int NT = 512;
constexpr int DM = 1024, NBATCH = 8, SEQ = 2048, CTXL = 256, TPB = 2304, MROWS = NBATCH * TPB, DEPTH = 4, DIN = 5792, DFF = 2816;
constexpr int ZW = 2816, GW = 4096, GE = 512;
constexpr float EPS = 1e-6f;
constexpr float LOG2E = 1.4426950408889634f;
constexpr int Z_QA = 0, Z_KA = 256, Z_VA = 384, Z_QC = 512, Z_KC = 768, Z_VC = 896, Z_QBA = 1024, Z_KVBA = 1280, Z_KBR = 1408, Z_QBF = 1536, Z_KVBF = 1920, Z_UM = 2432;

constexpr size_t MiB = (size_t)1 << 20;
constexpr size_t WS_MODP = 0, WS_MOD = 7 * MiB, WS_ROPE = 7 * MiB + 917504, WS_BAR = WS_ROPE + 16384, BAR_BYTES = 16384;
constexpr size_t WS_W = 8 * MiB;
constexpr size_t WS_WCAT = WS_W, WS_WBT = WS_W + 27 * MiB / 2, WS_WO = WS_W + 31 * MiB / 2, WS_W13 = WS_W + 35 * MiB / 2, WS_W2 = WS_W + 57 * MiB / 2;
constexpr size_t WS_X = 42 * MiB, WS_H = 114 * MiB, WS_A = 150 * MiB, WS_B = 294 * MiB, WS_O = 366 * MiB, WS_GE = 402 * MiB, WS_END = 420 * MiB;
constexpr size_t AT_QA = 0, AT_KA = 9 * MiB, AT_VAT = 27 * MiB / 2, AT_QC = 18 * MiB, AT_KC = 27 * MiB, AT_VCT = 63 * MiB / 2, AT_QB = 36 * MiB, AT_KB = 99 * MiB / 2, AT_VBT = 63 * MiB;
constexpr int LDS_BYTES = 147456;
constexpr int MODSZ = DEPTH * 9 * 6144;

struct Params {
    const float *x, *c, *ctx, *c_ctx, *ada_w, *ada_b, *mix_pre_g, *mix_post_g, *ffn_pre_g, *ffn_post_g, *w_in, *a_qn_g, *a_kn_g, *b_qa_g, *b_kva_g,
        *b_w_qb, *b_w_kvb, *c_sink, *d_w_pool, *d_scale, *w_branch, *w_out, *w_ffn1, *w_ffn3, *w_ffn2;
    float* out; unsigned char* ws;
    int ph_lo, ph_hi;
};

typedef const __attribute__((address_space(4))) Params& CPARAMS;
__device__ __forceinline__ unsigned f2bf(float f) { unsigned u = __builtin_bit_cast(unsigned, f); return (u + 0x7fffu + ((u >> 16) & 1u)) >> 16; }
__device__ __forceinline__ unsigned pk2(float lo, float hi) { return f2bf(lo) | (f2bf(hi) << 16); }
__device__ __forceinline__ float bf2f(unsigned b) { return __builtin_bit_cast(float, b << 16); }
__device__ __forceinline__ float bflo(unsigned w) { return __builtin_bit_cast(float, w << 16); }
__device__ __forceinline__ float bfhi(unsigned w) { return __builtin_bit_cast(float, w & 0xffff0000u); }
__device__ __forceinline__ unsigned cvt_pk_bf16(float lo, float hi) { unsigned r; asm volatile("v_cvt_pk_bf16_f32 %0, %1, %2" : "=v"(r) : "v"(lo), "v"(hi)); return r; }
template <int N> __device__ __forceinline__ float row_ror(float v) { return __builtin_bit_cast(float, __builtin_amdgcn_update_dpp(0, __builtin_bit_cast(int, v), 0x120 + N, 0xf, 0xf, false)); }
__device__ __forceinline__ float row16_sum(float v) { v += row_ror<8>(v); v += row_ror<4>(v); v += row_ror<2>(v); v += row_ror<1>(v); return v; }
__device__ __forceinline__ void permlane32_swap_asm(unsigned& a, unsigned& b) { asm volatile("s_nop 1\n\tv_permlane32_swap_b32 %0, %1" : "+v"(a), "+v"(b)); }
__device__ __forceinline__ float xhalf_sum(float x) { unsigned a = __builtin_bit_cast(unsigned, x), b = a; permlane32_swap_asm(a, b); return __builtin_bit_cast(float, a) + __builtin_bit_cast(float, b); }
__device__ __forceinline__ float xhalf_max(float x) { unsigned a = __builtin_bit_cast(unsigned, x), b = a; permlane32_swap_asm(a, b); return fmaxf(__builtin_bit_cast(float, a), __builtin_bit_cast(float, b)); }
__device__ __forceinline__ float wave_sum(float v) {
    v = row16_sum(v);
    unsigned a = __builtin_bit_cast(unsigned, v), b = a;
    asm volatile("s_nop 1\n\tv_permlane16_swap_b32 %0, %1" : "+v"(a), "+v"(b));
    return xhalf_sum(__builtin_bit_cast(float, a) + __builtin_bit_cast(float, b));
}
__device__ __forceinline__ float fast_sigmoid(float x) { return __builtin_amdgcn_rcpf(1.0f + __builtin_amdgcn_exp2f(-x * LOG2E)); }
__device__ __forceinline__ int tid_l() { int t = threadIdx.x; asm volatile("" : "+v"(t)); return t; }
__device__ __forceinline__ int bid_l() { int b = blockIdx.x; asm volatile("" : "+s"(b)); return b; }
#define LDS_WAIT() asm volatile("s_waitcnt lgkmcnt(0)" ::: "memory")

namespace pg8 {
constexpr int BM = 256, BK = 64, HALF = 128, HTB = HALF * BK * 2, STAGE_BYTES = 8 * HTB, NXCD = 8, WGM = 8;
__host__ __device__ __forceinline__ int lds_byte(int r, int c) { const int st = (r >> 4) * 2 + (c >> 5), rr = r & 15, cc = c & 31, ob = rr * 64 + cc * 2; return st * 1024 + (ob ^ (((ob >> 9) & 1) << 5)); }
__host__ __device__ __forceinline__ void stage_rc(int b, int& R, int& C) { const int st = b / 1024, sb = b % 1024, swz = sb ^ (((sb >> 9) & 1) << 5); R = (st >> 1) * 16 + swz / 64; C = (st & 1) * 32 + (swz % 64) / 2; }
__host__ __device__ __forceinline__ int perm32(int rho) { const int n = rho >> 4, i = rho & 15; return 8 * (i >> 2) + 4 * n + (i & 3); }
struct Unit { int pm, pn, k0, nt, part; };
struct Gemm { const bf16_t* A; const bf16_t* Bt; int M, N, K; };
struct StaticOrder {
    int nM, nN, nwg, G, c, skip, split, ktot;
    __host__ __device__ void init(int M, int N, int K, int G_, int c_, int skip_ = 0, int split_ = 0) {
        skip = skip_ | split_; split = split_; ktot = K / BK; nM = skip ? 64 : M / BM; nN = N / BM; nwg = nM * nN + (split ? 8 * nN * 4 : 0); G = G_; c = c_; }
    __host__ __device__ bool next(int i, Unit& u) const {
        const long L = (long)i * G + c; if (L >= nwg) return false;
        const int nmain = nM * nN;
        const bool sub = L >= nmain;
        const int su = (int)L - nmain, cu = su >> 2, pt = su & 3;
        const int q = (ktot / 8) * 2, rem = ktot - 4 * q, nbig = rem / 2;
        int wgid = sub ? 0 : (int)L; { const int qq = nmain / NXCD, r = nmain % NXCD, xcd = wgid % NXCD, off = wgid / NXCD; wgid = (xcd < r ? xcd * (qq + 1) : r * (qq + 1) + (xcd - r) * qq) + off; }
        const int nig = WGM * nN, gid = wgid / nig, fm = gid * WGM, gsz = (nM - fm) < WGM ? (nM - fm) : WGM;
        int pm = fm + ((wgid % nig) % gsz); const int pn = (wgid % nig) / gsz; if (skip) pm = pm + pm / 8 + 1;
        u.pm = sub ? 9 * (cu / nN) : pm; u.pn = sub ? cu % nN : pn;
        u.k0 = sub ? pt * q + 2 * (pt < nbig ? pt : nbig) : 0; u.nt = sub ? q + (pt < nbig ? 2 : 0) : ktot; u.part = sub ? pt + 1 : 0;
        return true;
    }
    __device__ __forceinline__ void a_ready(const Unit&) const {}
    __device__ __forceinline__ void done(const Unit&) const {}
};

struct EpiP {
    static constexpr bool PERM = true, AFTER_DRAIN = false;
    bf16_t* O_; int ldc_; int mode_; int split_pn; bf16_t* O2; int ldc2; int mode2;
    bf16_t* Opart;
    __device__ __forceinline__ void operator()(const f32x4 (&acc)[2][2][4][2], const Unit& u, int wr, int wc, int fr, int fq) const {
        const bool hi = u.pn >= split_pn; bf16_t* O = hi ? O2 : O_; const int ldc = hi ? ldc2 : ldc_, mode = hi ? mode2 : mode_;
        if (u.part > 0) O = Opart + (size_t)(u.part - 1) * (2048 * 1024);
        const int row0 = (u.part > 0 ? (u.pm / 9) * BM : u.pm * BM) + wr * 64 + fr; const int col0 = (hi ? u.pn - split_pn : u.pn) * BM + wc * 32 + 8 * fq;
#pragma unroll
        for (int ai = 0; ai < 2; ++ai)
#pragma unroll
            for (int m = 0; m < 4; ++m) {
                const size_t row = (size_t)(row0 + ai * HALF + m * 16);
#pragma unroll
                for (int bj = 0; bj < 2; ++bj) {
                    f32x4 v0 = acc[ai][bj][m][0], v1 = acc[ai][bj][m][1]; const int c = col0 + bj * HALF;
                    if (mode == 2) {
                        const float o0 = v0[0] * fast_sigmoid(v0[0]) * v0[1], o1 = v0[2] * fast_sigmoid(v0[2]) * v0[3];
                        const float o2 = v1[0] * fast_sigmoid(v1[0]) * v1[1], o3 = v1[2] * fast_sigmoid(v1[2]) * v1[3];
                        u32x2 w; w.x = cvt_pk_bf16(o0, o1); w.y = cvt_pk_bf16(o2, o3);
                        *(u32x2*)(O + row * ldc + (c >> 1)) = w;
                    } else {
                        if (mode == 1) {
#pragma unroll
                            for (int e = 0; e < 4; ++e) { v0[e] = fast_sigmoid(v0[e]); v1[e] = fast_sigmoid(v1[e]); }
                        }
                        u32x4 w; w.x = cvt_pk_bf16(v0[0], v0[1]); w.y = cvt_pk_bf16(v0[2], v0[3]); w.z = cvt_pk_bf16(v1[0], v1[1]); w.w = cvt_pk_bf16(v1[2], v1[3]);
                        *(u32x4*)(O + row * ldc + c) = w;
                    }
                }
            }
    }
};
struct EpiF {
    static constexpr bool PERM = false, AFTER_DRAIN = false;
    float* O; int ldc;
    __device__ __forceinline__ void operator()(const f32x4 (&acc)[2][2][4][2], const Unit& u, int wr, int wc, int fr, int fq) const {
        const int row0 = u.pm * BM + wr * 64 + fr; const int col0 = u.pn * BM + wc * 32 + 4 * fq;
#pragma unroll
        for (int ai = 0; ai < 2; ++ai)
#pragma unroll
            for (int m = 0; m < 4; ++m) {
                float* rp = O + (size_t)(row0 + ai * HALF + m * 16) * ldc + col0;
#pragma unroll
                for (int bj = 0; bj < 2; ++bj)
#pragma unroll
                    for (int n = 0; n < 2; ++n) *(f32x4*)(rp + bj * HALF + n * 16) = acc[ai][bj][m][n];
            }
    }
};

template <class Epi, class Sched>
__device__ __forceinline__ void gemm_phase(LAS unsigned char* lds, const Gemm g, const Sched& S, const Epi& E) {
    const int tid = tid_l(), wid = __builtin_amdgcn_readfirstlane(tid >> 6), lane = tid & 63, wr = wid >> 2, wc = wid & 3, fr = lane & 15, fq = lane >> 4;
    const int K = g.K;
    unsigned voffA[2], voffB[2];
#pragma unroll
    for (int i = 0; i < 2; ++i) { int R, C; stage_rc(tid * 16 + i * 8192, R, C); const int Rb = Epi::PERM ? ((R & ~31) + perm32(R & 31)) : R;
        voffA[i] = (unsigned)(R * K + C) * 2u; voffB[i] = (unsigned)(Rb * K + C) * 2u; }
    const size_t kstep = (size_t)(BK * 2);
    const size_t hstep = (size_t)HALF * K * 2;
    const size_t tstep = 2 * hstep;
    const unsigned ldsw = (unsigned)wid * 1024u;
    const int aoff = lds_byte(wr * 64 + fr, fq * 8), boff = lds_byte(wc * 32 + fr, fq * 8);
#define PG8_SA(b, h) (((b) * 2 + (h)) * HTB)
#define PG8_SB(b, h) ((4 + (b) * 2 + (h)) * HTB)
#define PG8_STAGE(bufoff, gbase, voff) do { _Pragma("unroll") for (int _i = 0; _i < 2; ++_i) \
        __builtin_amdgcn_global_load_lds((const unsigned*)((const char*)(gbase) + (voff)[_i]), (LAS unsigned*)(lds + (bufoff) + ldsw + _i * 8192), 16, 0, 0); } while (0)
#define PG8_LDA(dst, b, h) do { _Pragma("unroll") for (int m = 0; m < 4; ++m) _Pragma("unroll") for (int k = 0; k < 2; ++k) dst[m][k] = *(const LAS bf16x8*)(lds + PG8_SA(b, h) + aoff + m * 2048 + k * 1024); } while (0)
#define PG8_LDB(dst, b, h) do { _Pragma("unroll") for (int n = 0; n < 2; ++n) _Pragma("unroll") for (int k = 0; k < 2; ++k) dst[n][k] = *(const LAS bf16x8*)(lds + PG8_SB(b, h) + boff + n * 2048 + k * 1024); } while (0)
#define PG8_MMA(ai, bj, At, Bt) do { __builtin_amdgcn_s_setprio(1); _Pragma("unroll") for (int m = 0; m < 4; ++m) _Pragma("unroll") for (int n = 0; n < 2; ++n) _Pragma("unroll") for (int k = 0; k < 2; ++k) \
        acc[ai][bj][m][n] = __builtin_amdgcn_mfma_f32_16x16x32_bf16(Bt[n][k], At[m][k], acc[ai][bj][m][n], 0, 0, 0); __builtin_amdgcn_s_setprio(0); } while (0)
#define PG8_WAIT_V(n) asm volatile("s_waitcnt vmcnt(" #n ")" ::: "memory")
#define PG8_WAIT_L(n) asm volatile("s_waitcnt lgkmcnt(" #n ")" ::: "memory")
#define PG8_BAR __builtin_amdgcn_s_barrier()
#define PG8_SCHED __builtin_amdgcn_sched_barrier(0)
    Unit cur, nxt; int ui = 0;
    if (!S.next(0, cur)) return;
    f32x4 acc[2][2][4][2];
#pragma unroll
    for (int a = 0; a < 2; ++a)
#pragma unroll
        for (int b = 0; b < 2; ++b)
#pragma unroll
            for (int m = 0; m < 4; ++m)
#pragma unroll
                for (int n = 0; n < 2; ++n) acc[a][b][m][n] = (f32x4){0.f, 0.f, 0.f, 0.f};
    bf16x8 At[4][2], B0[2][2], B1[2][2];
    const char* cA = (const char*)g.A + (size_t)cur.pm * tstep + (size_t)cur.k0 * kstep; const char* cB = (const char*)g.Bt + (size_t)cur.pn * tstep + (size_t)cur.k0 * kstep;
    PG8_STAGE(PG8_SB(0, 0), cB, voffB); PG8_STAGE(PG8_SB(0, 1), cB + hstep, voffB); PG8_STAGE(PG8_SA(0, 0), cA, voffA); PG8_STAGE(PG8_SA(0, 1), cA + hstep, voffA);
    if (wr == 1) PG8_BAR;
    PG8_WAIT_V(2); PG8_BAR;
    PG8_STAGE(PG8_SB(1, 0), cB + kstep, voffB); PG8_STAGE(PG8_SA(1, 0), cA + kstep, voffA); PG8_STAGE(PG8_SB(1, 1), cB + hstep + kstep, voffB);
    PG8_WAIT_V(6); PG8_BAR;
    for (;;) {
        const bool has_next = S.next(ui + 1, nxt);
        const char* nA = has_next ? (const char*)g.A + (size_t)nxt.pm * tstep + (size_t)nxt.k0 * kstep : cA; const char* nB = has_next ? (const char*)g.Bt + (size_t)nxt.pn * tstep + (size_t)nxt.k0 * kstep : cB;
        const int nt = cur.nt;
        for (int t = 0; t < nt; t += 2) {
            const bool last = (t == nt - 2);
            const char* a1 = cA + (size_t)(t + 1) * kstep;
            const char* a2 = last ? nA : cA + (size_t)(t + 2) * kstep; const char* b2 = last ? nB : cB + (size_t)(t + 2) * kstep;
            const char* a3 = a2 + kstep; const char* b3 = b2 + kstep;
            PG8_LDB(B0, 0, 0); PG8_LDB(B1, 0, 1); PG8_SCHED; PG8_LDA(At, 0, 0); PG8_STAGE(PG8_SA(1, 1), a1 + hstep, voffA);
            PG8_WAIT_V(8); PG8_WAIT_L(0); PG8_BAR; PG8_MMA(0, 0, At, B0); PG8_MMA(0, 1, At, B1); PG8_BAR; PG8_SCHED;
            PG8_LDA(At, 0, 1); PG8_STAGE(PG8_SB(0, 0), b2, voffB); PG8_STAGE(PG8_SB(0, 1), b2 + hstep, voffB); PG8_STAGE(PG8_SA(0, 0), a2, voffA);
            PG8_WAIT_V(8); PG8_WAIT_L(0); PG8_BAR; PG8_MMA(1, 0, At, B0); PG8_MMA(1, 1, At, B1); PG8_BAR; PG8_SCHED;
            PG8_LDB(B0, 1, 0); PG8_LDB(B1, 1, 1); PG8_SCHED; PG8_LDA(At, 1, 0); PG8_STAGE(PG8_SA(0, 1), a2 + hstep, voffA);
            PG8_WAIT_V(8); PG8_WAIT_L(0); PG8_BAR; PG8_MMA(0, 0, At, B0); PG8_MMA(0, 1, At, B1); PG8_BAR; PG8_SCHED;
            PG8_LDA(At, 1, 1); PG8_STAGE(PG8_SB(1, 0), b3, voffB); PG8_STAGE(PG8_SB(1, 1), b3 + hstep, voffB); PG8_STAGE(PG8_SA(1, 0), a3, voffA);
            PG8_WAIT_V(8); PG8_WAIT_L(0); PG8_BAR; PG8_MMA(1, 0, At, B0); PG8_MMA(1, 1, At, B1); PG8_BAR; PG8_SCHED;
        }
        if (wr == 0) PG8_BAR;
        E(acc, cur, wr, wc, fr, fq);
        if (!has_next) break;
#pragma unroll
        for (int a = 0; a < 2; ++a)
#pragma unroll
            for (int b = 0; b < 2; ++b)
#pragma unroll
                for (int m = 0; m < 4; ++m)
#pragma unroll
                    for (int n = 0; n < 2; ++n) acc[a][b][m][n] = (f32x4){0.f, 0.f, 0.f, 0.f};
        cur = nxt; cA = nA; cB = nB; ++ui;
        if (wr == 1) PG8_BAR;
    }
    PG8_WAIT_V(0);
    PG8_BAR;
#undef PG8_SA
#undef PG8_SB
#undef PG8_STAGE
#undef PG8_LDA
#undef PG8_LDB
#undef PG8_MMA
#undef PG8_WAIT_V
#undef PG8_WAIT_L
#undef PG8_BAR
#undef PG8_SCHED
}
}

__device__ __forceinline__ void mod_partial_phase(CPARAMS p, unsigned char* ws_, LAS unsigned char* lds) {
    LAS float* s = (LAS float*)lds;
    float* modp = (float*)(ws_ + WS_MODP);
    const int tid = tid_l();
    for (int it = bid_l(); it < 384; it += gridDim.x) {
        const int l = it / 96, r96 = it % 96, jb = r96 / 8, kc = r96 % 8;
        __syncthreads();
        for (int i = tid; i < 9 * 128; i += NT) { const int r9 = i >> 7, k = i & 127; const float v = r9 < 8 ? p.c[r9 * DM + kc * 128 + k] : p.c_ctx[kc * 128 + k]; s[i] = v / (1.0f + __expf(-v)); }
        __syncthreads();
        const int j = jb * 512 + tid;
        float a0 = 0.f, a1 = 0.f, a2 = 0.f, a3 = 0.f, a4 = 0.f, a5 = 0.f, a6 = 0.f, a7 = 0.f, a8 = 0.f;
        const float* w = p.ada_w + ((size_t)l * DM + kc * 128) * 6144 + j;
#pragma unroll 32
        for (int k = 0; k < 128; ++k) {
            const float wv = w[(size_t)k * 6144];
            a0 += s[k] * wv; a1 += s[128 + k] * wv; a2 += s[256 + k] * wv; a3 += s[384 + k] * wv; a4 += s[512 + k] * wv;
            a5 += s[640 + k] * wv; a6 += s[768 + k] * wv; a7 += s[896 + k] * wv; a8 += s[1024 + k] * wv;
        }
        float* o = modp + (size_t)kc * MODSZ + (size_t)l * 9 * 6144 + j;
        o[0] = a0; o[6144] = a1; o[2 * 6144] = a2; o[3 * 6144] = a3; o[4 * 6144] = a4; o[5 * 6144] = a5; o[6 * 6144] = a6; o[7 * 6144] = a7; o[8 * 6144] = a8;
    }
    __syncthreads();
}
__device__ __forceinline__ void rope_table_phase(CPARAMS p, unsigned char* ws_) {
    float* tab = (float*)(ws_ + WS_ROPE);
    for (int i = bid_l() * NT + tid_l(); i < 1024 + 512; i += gridDim.x * NT) {
        if (i < 1024) { const int pp = i >> 4, f = i & 15; const float inv = powf(10000.0f, -(float)f / 16.0f); const float a = (float)pp * inv; tab[i] = cosf(a); tab[1024 + i] = sinf(a); }
        else { const int q = i - 1024, pp = q >> 3, f = q & 7; const float inv = powf(10000.0f, -(float)f / 8.0f); const float a = (float)pp * inv; tab[2048 + q] = cosf(a); tab[2560 + q] = sinf(a); }
    }
}
__device__ __forceinline__ void mod_reduce_phase(CPARAMS p, unsigned char* ws_) {
    const float* modp = (const float*)(ws_ + WS_MODP); float* mod = (float*)(ws_ + WS_MOD);
    for (int i = bid_l() * NT + tid_l(); i < MODSZ; i += gridDim.x * NT) {
        const int l = i / (9 * 6144), j = i % 6144; float s = p.ada_b[l * 6144 + j];
#pragma unroll
        for (int kc = 0; kc < 8; ++kc) s += modp[(size_t)kc * MODSZ + i];
        mod[i] = s;
    }
}
__device__ __forceinline__ void tr_item(const float* W, int ldw, bf16_t* WT, int ldt, LAS float* scr, int lane, bool gperm = false, bool kperm = false) {
#pragma unroll
    for (int hf = 0; hf < 2; ++hf) {
        float tv[32];
#pragma unroll
        for (int i = 0; i < 32; ++i) tv[i] = W[(size_t)(hf * 32 + i) * ldw + lane];
        __builtin_amdgcn_sched_barrier(0);
#pragma unroll
        for (int i = 0; i < 32; ++i) scr[(hf * 32 + i) * 65 + lane] = tv[i];
    }
    LDS_WAIT(); asm volatile("" ::: "memory");
    const int c = lane & 7;
#pragma unroll
    for (int j = 0; j < 8; ++j) { const int n = (lane >> 3) + 8 * j; const LAS float* s = scr + (8 * c) * 65 + n;
        u32x4 o; o.x = pk2(s[0 * 65], s[1 * 65]); o.y = pk2(s[2 * 65], s[3 * 65]); o.z = pk2(s[4 * 65], s[5 * 65]); o.w = pk2(s[6 * 65], s[7 * 65]);
        const int nd = gperm ? ((n & 4) << 3) + ((n >> 3) << 2) + (n & 3) : n;
        if (kperm) { *(u32x2*)(WT + (size_t)nd * ldt + 4 * c) = (u32x2){o.x, o.y}; *(u32x2*)(WT + (size_t)nd * ldt + 32 + 4 * c) = (u32x2){o.z, o.w}; }
        else *(u32x4*)(WT + (size_t)nd * ldt + 8 * c) = o; }
    LDS_WAIT(); asm volatile("" ::: "memory");
}
#define TR_JOBP(Wp, ldw_, WTp, ldt_, K_, N_, GP_) { const int nblk = (N_) / 64; const int items = ((K_) / 64) * nblk; \
    if (r < items) { const int kb = r / nblk, nb = r % nblk; tr_item((Wp) + (size_t)(64 * kb) * (ldw_) + 64 * nb, (ldw_), (WTp) + (size_t)(64 * nb) * (ldt_) + 64 * kb, (ldt_), scr, lane, (GP_) == 1, (GP_) == 2); continue; } r -= items; }
#define TR_JOB(Wp, ldw_, WTp, ldt_, K_, N_) TR_JOBP(Wp, ldw_, WTp, ldt_, K_, N_, 0)
__device__ __forceinline__ void prep_weights(CPARAMS p, unsigned char* ws_, int l, LAS unsigned char* lds, int mask, int widx, int nwork) {
    const int tid = tid_l(), lane = tid & 63, wave = __builtin_amdgcn_readfirstlane(tid >> 6);
    bf16_t* Wcat = (bf16_t*)(ws_ + WS_WCAT); bf16_t* Wbt = (bf16_t*)(ws_ + WS_WBT); bf16_t* Wo = (bf16_t*)(ws_ + WS_WO);
    bf16_t* W13 = (bf16_t*)(ws_ + WS_W13); bf16_t* W2 = (bf16_t*)(ws_ + WS_W2);
    const float* win = p.w_in + (size_t)l * DM * DIN;
    if (mask & 1) {
        LAS float* As = (LAS float*)lds;
        for (int it = widx; it < 288; it += nwork) {
            int type, jc, ib;
            if (it < 96) { type = 0; ib = it / 6; jc = it % 6; } else if (it < 224) { type = 1; ib = (it - 96) / 8; jc = (it - 96) % 8; } else { type = 2; ib = (it - 224) / 4; jc = (it - 224) % 4; }
            const int Kf = type == 0 ? 256 : (type == 1 ? 128 : 64);
            const int col0 = type == 0 ? 512 : (type == 1 ? 768 : 1440 + jc * 64);
            const float* gain = type == 0 ? p.b_qa_g + l * 256 : (type == 1 ? p.b_kva_g + l * 128 : nullptr);
            const int i0 = ib * 64, st = Kf + 1;
            const float* Wsm; int ldW, jbase, rowbase;
            if (type == 0) { Wsm = p.b_w_qb + (size_t)l * 256 * 384; ldW = 384; jbase = jc * 64; rowbase = Z_QBF; }
            else if (type == 1) { Wsm = p.b_w_kvb + (size_t)l * 128 * 512; ldW = 512; jbase = jc * 64; rowbase = Z_KVBF; }
            else { Wsm = p.d_w_pool + ((size_t)l * 4 + jc) * 64 * 64; ldW = 64; jbase = 0; rowbase = Z_UM + jc * 64; }
            LAS float* Ws = As + 64 * 257;
            __syncthreads();
            {
                const int lg = type == 0 ? 8 : (type == 1 ? 7 : 6), nit = (64 * Kf) / NT;
                for (int i0b = 0; i0b < nit; i0b += 8) {
                    float ta[8], tw[8], tg[8];
#pragma unroll
                    for (int q = 0; q < 8; ++q) { const int e = tid + (i0b + q) * NT, i = e >> lg, c = e & (Kf - 1);
                        ta[q] = win[(size_t)(i0 + i) * DIN + col0 + c]; tg[q] = gain ? gain[c] : 1.0f; tw[q] = Wsm[(size_t)(e >> 6) * ldW + jbase + (e & 63)]; }
                    __builtin_amdgcn_sched_barrier(0);
#pragma unroll
                    for (int q = 0; q < 8; ++q) { const int e = tid + (i0b + q) * NT, i = e >> lg, c = e & (Kf - 1); As[i * st + c] = ta[q] * tg[q]; Ws[e] = tw[q]; }
                }
            }
            __syncthreads();
            const int i = lane;
            float a0 = 0.f, a1 = 0.f, a2 = 0.f, a3 = 0.f, a4 = 0.f, a5 = 0.f, a6 = 0.f, a7 = 0.f;
            const LAS float* ap = As + i * st; const LAS float* wp = Ws + wave * 8;
#pragma unroll 4
            for (int c = 0; c < Kf; ++c) {
                const float a = ap[c]; const f32x4 w0 = *(const LAS f32x4*)(wp + c * 64), w1 = *(const LAS f32x4*)(wp + c * 64 + 4);
                a0 += a * w0.x; a1 += a * w0.y; a2 += a * w0.z; a3 += a * w0.w; a4 += a * w1.x; a5 += a * w1.y; a6 += a * w1.z; a7 += a * w1.w;
            }
            const int jl = wave * 8;
            if (type == 2) { const float* sc = p.d_scale + l * 256 + jc * 64 + jl; a0 *= sc[0]; a1 *= sc[1]; a2 *= sc[2]; a3 *= sc[3]; a4 *= sc[4]; a5 *= sc[5]; a6 *= sc[6]; a7 *= sc[7]; }
            bf16_t* wo = Wcat + (size_t)(rowbase + jbase + jl) * DM + i0 + i;
            wo[0] = (bf16_t)f2bf(a0); wo[DM] = (bf16_t)f2bf(a1); wo[2 * DM] = (bf16_t)f2bf(a2); wo[3 * DM] = (bf16_t)f2bf(a3);
            wo[4 * DM] = (bf16_t)f2bf(a4); wo[5 * DM] = (bf16_t)f2bf(a5); wo[6 * DM] = (bf16_t)f2bf(a6); wo[7 * DM] = (bf16_t)f2bf(a7);
        }
        __syncthreads();
    }
    LAS float* scr = (LAS float*)(lds + wave * 16640);
    const int gw = widx * 8 + wave, NGW = nwork * 8;
    constexpr int N0 = 128 + 128 + 96 + 16 + 1024, N2 = 704;
    if (mask & 1) for (int it = gw; it < N0; it += NGW) {
        int r = it;
        TR_JOB(win + 0, DIN, Wcat + (size_t)0 * DM, DM, 1024, 512)
        TR_JOB(win + 928, DIN, Wcat + (size_t)512 * DM, DM, 1024, 512)
        TR_JOB(win + 512, DIN, Wcat + (size_t)1024 * DM, DM, 1024, 384)
        TR_JOB(win + 896, DIN, Wcat + (size_t)1408 * DM, DM, 1024, 64)
        TR_JOBP(win + 1696, DIN, Wcat + (size_t)ZW * DM, DM, 1024, 4096, 1)
    }
    if (mask & 2) for (int it = gw; it < 512; it += NGW) {
        int r = it;
        TR_JOB(p.w_branch + (size_t)l * 1024 * 1024, 1024, Wbt, 1024, 1024, 1024)
        TR_JOBP(p.w_out + (size_t)l * 1024 * 1024, 1024, Wo, 1024, 1024, 1024, 2)
    }
    if (mask & 4) for (int it = gw; it < 1408; it += NGW) {
        int r = it;
        TR_JOB(p.w_ffn1 + (size_t)l * DM * DFF, DFF, W13, 2048, 1024, 2816)
        TR_JOB(p.w_ffn3 + (size_t)l * DM * DFF, DFF, W13 + 1024, 2048, 1024, 2816)
    }
    if (mask & 8) for (int it = gw; it < N2; it += NGW) {
        int r = it;
        TR_JOB(p.w_ffn2 + (size_t)l * DFF * DM, DM, W2, DFF, 2816, 1024)
    }
    __syncthreads();
}

template <int MODE, bool DRY = false>
__device__ __forceinline__ void row_phase(CPARAMS p, unsigned char* ws_, int l, int nsplit) {
    const int lane = tid_l() & 63, wave = tid_l() >> 6;
    const float* mod = (const float*)(ws_ + WS_MOD);
    bf16_t* xres = (bf16_t*)(ws_ + WS_X);
    const bf16_t* ybuf = (const bf16_t*)(ws_ + WS_B); bf16_t* hbuf = (bf16_t*)(ws_ + (DRY ? WS_O : WS_H));
    const int gw = bid_l() * 8 + wave, NGW = gridDim.x * 8;
    const int rpw = (MROWS + NGW - 1) / NGW;
    const bool fin = (MODE == 2 && l == DEPTH - 1);
    const int lh = MODE == 2 ? l + 1 : l;
    const float* gp = (MODE == 1 ? p.mix_post_g : p.ffn_post_g) + l * DM;
    const float* gpre = (MODE == 1 ? p.ffn_pre_g : p.mix_pre_g) + (fin ? 0 : lh) * DM;
    f32x4 gt[4], gg[4], gq[4], s1[4], s2[4];
#pragma unroll
    for (int j = 0; j < 4; ++j) { gg[j] = ((const f32x4*)gp)[lane + 64 * j]; gq[j] = ((const f32x4*)gpre)[lane + 64 * j]; gt[j] = gg[j]; s1[j] = gg[j]; s2[j] = gg[j]; }
    int cur_mrow = -1;
    auto load_params = [&](int mrow) {
        cur_mrow = mrow;
        const float* gate = mod + ((size_t)l * 9 + mrow) * 6144 + (MODE == 1 ? 2 : 5) * DM;
        const float* sh = mod + ((size_t)(fin ? 0 : lh) * 9 + mrow) * 6144 + (MODE == 1 ? 3 : 0) * DM;
        const float* sc = sh + DM;
#pragma unroll
        for (int j = 0; j < 4; ++j) { if (MODE >= 1) gt[j] = ((const f32x4*)gate)[lane + 64 * j]; s1[j] = ((const f32x4*)sh)[lane + 64 * j]; s2[j] = ((const f32x4*)sc)[lane + 64 * j]; }
    };
    auto finish_row = [&](int row, int b, int tau, f32x4 (&xv)[4], f32x4 (&yv)[4]) {
        if (MODE >= 1) {
            float ss = 0.f;
#pragma unroll
            for (int j = 0; j < 4; ++j) ss += (yv[j].x * yv[j].x + yv[j].y * yv[j].y) + (yv[j].z * yv[j].z + yv[j].w * yv[j].w);
            const float rstd = rsqrtf(wave_sum(ss) * (1.0f / DM) + EPS);
#pragma unroll
            for (int j = 0; j < 4; ++j) xv[j] = xv[j] + gt[j] * (yv[j] * rstd * gg[j]);
        }
        if (fin) {
            if (DRY) return;
            float* o = p.out + ((size_t)b * SEQ + (tau - CTXL)) * DM;
#pragma unroll
            for (int j = 0; j < 4; ++j) ((f32x4*)o)[lane + 64 * j] = xv[j];
            return;
        }
        if (!DRY) {
#pragma unroll
        for (int j = 0; j < 4; ++j) { u32x2 w; w.x = pk2(xv[j].x, xv[j].y); w.y = pk2(xv[j].z, xv[j].w); ((u32x2*)(xres + (size_t)row * DM))[lane + 64 * j] = w; }
        }
        float ss = 0.f;
#pragma unroll
        for (int j = 0; j < 4; ++j) ss += (xv[j].x * xv[j].x + xv[j].y * xv[j].y) + (xv[j].z * xv[j].z + xv[j].w * xv[j].w);
        const float rstd = rsqrtf(wave_sum(ss) * (1.0f / DM) + EPS);
#pragma unroll
        for (int j = 0; j < 4; ++j) {
            const f32x4 hv = (xv[j] * rstd * gq[j]) * (s2[j] + 1.0f) + s1[j];
            u32x2 w; w.x = pk2(hv.x, hv.y); w.y = pk2(hv.z, hv.w);
            ((u32x2*)(hbuf + (size_t)row * DM))[lane + 64 * j] = w;
        }
    };
    auto one_row = [&](int row) {
        const int b = row / TPB, tau = row % TPB, mrow = tau < CTXL ? 8 : b;
        if (MODE >= 1 && l == DEPTH - 1 && tau < CTXL) return;
        if (mrow != cur_mrow) load_params(mrow);
        const float* src = tau < CTXL ? p.ctx + ((size_t)b * CTXL + tau) * DM : p.x + ((size_t)b * SEQ + (tau - CTXL)) * DM;
        f32x4 xv[4], yv[4];
        if (MODE >= 1 && nsplit == 4 && tau < CTXL) {
            u32x2 xraw[4], yraw[4][4];
            const bf16_t* pp = (const bf16_t*)(ws_ + WS_O) + ((size_t)b * CTXL + tau) * DM;
#pragma unroll
            for (int j = 0; j < 4; ++j) { xraw[j] = ((const u32x2*)(xres + (size_t)row * DM))[lane + 64 * j];
#pragma unroll
                for (int q = 0; q < 4; ++q) yraw[j][q] = ((const u32x2*)(pp + (size_t)q * (2048 * 1024)))[lane + 64 * j]; }
            __builtin_amdgcn_sched_barrier(0);
#pragma unroll
            for (int j = 0; j < 4; ++j) {
                xv[j] = (f32x4){bflo(xraw[j].x), bfhi(xraw[j].x), bflo(xraw[j].y), bfhi(xraw[j].y)};
                yv[j] = (f32x4){bflo(yraw[j][0].x), bfhi(yraw[j][0].x), bflo(yraw[j][0].y), bfhi(yraw[j][0].y)};
#pragma unroll
                for (int q = 1; q < 4; ++q) yv[j] = yv[j] + (f32x4){bflo(yraw[j][q].x), bfhi(yraw[j][q].x), bflo(yraw[j][q].y), bfhi(yraw[j][q].y)};
            }
        } else {
            u32x2 xraw[4], yraw[4];
#pragma unroll
            for (int j = 0; j < 4; ++j) {
                if (MODE == 0) xv[j] = ((const f32x4*)src)[lane + 64 * j]; else xraw[j] = ((const u32x2*)(xres + (size_t)row * DM))[lane + 64 * j];
                if (MODE >= 1) yraw[j] = ((const u32x2*)(ybuf + (size_t)row * DM))[lane + 64 * j];
            }
            __builtin_amdgcn_sched_barrier(0);
            if (MODE >= 1) {
#pragma unroll
                for (int j = 0; j < 4; ++j) { xv[j] = (f32x4){bflo(xraw[j].x), bfhi(xraw[j].x), bflo(xraw[j].y), bfhi(xraw[j].y)}; yv[j] = (f32x4){bflo(yraw[j].x), bfhi(yraw[j].x), bflo(yraw[j].y), bfhi(yraw[j].y)}; }
            }
        }
        finish_row(row, b, tau, xv, yv);
    };
    for (int i = 0; i < rpw; i += 3) {
        const int row0 = gw * rpw + i; if (row0 >= MROWS) break;
        const int b0 = row0 / TPB, tau0 = row0 % TPB, mrow0 = tau0 < CTXL ? 8 : b0;
        const bool same = (i + 3 <= rpw) && (row0 + 2 < MROWS) && (MODE >= 1) && ((tau0 + 2) < TPB) && ((tau0 < CTXL) == ((tau0 + 2) < CTXL)) && !(tau0 < CTXL && (nsplit == 4 || l == DEPTH - 1));
        if (same) {
            if (mrow0 != cur_mrow) load_params(mrow0);
            u32x2 xr[3][4], yr[3][4];
#pragma unroll
            for (int q = 0; q < 3; ++q)
#pragma unroll
                for (int j = 0; j < 4; ++j) { xr[q][j] = ((const u32x2*)(xres + (size_t)(row0 + q) * DM))[lane + 64 * j]; yr[q][j] = ((const u32x2*)(ybuf + (size_t)(row0 + q) * DM))[lane + 64 * j]; }
            __builtin_amdgcn_sched_barrier(0);
#pragma unroll
            for (int q = 0; q < 3; ++q) {
                f32x4 xv[4], yv[4];
#pragma unroll
                for (int j = 0; j < 4; ++j) { xv[j] = (f32x4){bflo(xr[q][j].x), bfhi(xr[q][j].x), bflo(xr[q][j].y), bfhi(xr[q][j].y)}; yv[j] = (f32x4){bflo(yr[q][j].x), bfhi(yr[q][j].x), bflo(yr[q][j].y), bfhi(yr[q][j].y)}; }
                finish_row(row0 + q, b0, tau0 + q, xv, yv);
            }
        } else {
            for (int q = 0; q < 3; ++q) { if (i + q < rpw && row0 + q < MROWS) one_row(row0 + q); }
        }
    }
}

__device__ __forceinline__ void head64(const LAS bf16_t* zsrc, int nh, const LAS float* gain, bool rope, const LAS float* cs64, int prow, int pcol, float scale, bf16_t* dst, size_t head_stride, int lane) {
    const int hh = lane >> 4, q = lane & 15, hs = hh % nh;
    const unsigned a = *(const LAS unsigned*)(zsrc + hs * 64 + 2 * q), bb = *(const LAS unsigned*)(zsrc + hs * 64 + 32 + 2 * q);
    float x1a = bflo(a), x1b = bfhi(a), x2a = bflo(bb), x2b = bfhi(bb);
    if (gain) {
        float ss = (x1a * x1a + x1b * x1b) + (x2a * x2a + x2b * x2b);
        ss = row16_sum(ss);
        const float rstd = rsqrtf(ss * (1.0f / 64.0f) + EPS);
        x1a *= rstd * gain[2 * q]; x1b *= rstd * gain[2 * q + 1]; x2a *= rstd * gain[32 + 2 * q]; x2b *= rstd * gain[32 + 2 * q + 1];
    }
    if (rope) {
        const int pp = q < 8 ? prow : pcol, f = (2 * q) & 15;
        const float ca = cs64[pp * 16 + f], cb = cs64[pp * 16 + f + 1], sa = cs64[1024 + pp * 16 + f], sb = cs64[1024 + pp * 16 + f + 1];
        const float o1a = x1a * ca - x2a * sa, o2a = x1a * sa + x2a * ca, o1b = x1b * cb - x2b * sb, o2b = x1b * sb + x2b * cb;
        x1a = o1a; x2a = o2a; x1b = o1b; x2b = o2b;
    }
    if (hh < nh) {
        bf16_t* d = dst + (size_t)hh * head_stride;
        *(unsigned*)(d + 2 * q) = pk2(x1a * scale, x1b * scale);
        *(unsigned*)(d + 32 + 2 * q) = pk2(x2a * scale, x2b * scale);
    }
}
__device__ __forceinline__ void prep_phase(CPARAMS p, unsigned char* ws_, int l, LAS unsigned char* lds) {
    const int tid = tid_l(), lane = tid & 63, wave = tid >> 6;
    const bf16_t* z = (const bf16_t*)(ws_ + WS_A);
    unsigned char* at = ws_ + WS_B;
    bf16_t *Qa = (bf16_t*)(at + AT_QA), *Ka = (bf16_t*)(at + AT_KA), *VaT = (bf16_t*)(at + AT_VAT), *Qc = (bf16_t*)(at + AT_QC), *Kc = (bf16_t*)(at + AT_KC), *VcT = (bf16_t*)(at + AT_VCT);
    bf16_t *Qb = (bf16_t*)(at + AT_QB), *Kb = (bf16_t*)(at + AT_KB), *VbT = (bf16_t*)(at + AT_VBT);
    bf16_t* Ocat = (bf16_t*)(ws_ + WS_O);
    const float* tab = (const float*)(ws_ + WS_ROPE);
    LAS bf16_t* VT = (LAS bf16_t*)lds;
    LAS bf16_t* UM = VT + 512 * 40;
    LAS float* TAB = (LAS float*)(lds + 65536);
    LAS bf16_t* ZR = (LAS bf16_t*)(lds + 78336 + wave * 4864);
    const LAS float* cs64 = TAB; const LAS float* cs32 = TAB + 2048;
    const float scA = 0.125f * LOG2E, scB = 0.10206207261596575f * LOG2E;
    __syncthreads();
    { float tt[6];
#pragma unroll
      for (int q = 0; q < 6; ++q) tt[q] = tab[tid + q * NT];
      __builtin_amdgcn_sched_barrier(0);
#pragma unroll
      for (int q = 0; q < 6; ++q) TAB[tid + q * NT] = tt[q]; }
    if (tid < 64) { TAB[3072 + tid] = p.a_qn_g[l * 64 + tid]; TAB[3136 + tid] = p.a_kn_g[l * 64 + tid]; }
    __syncthreads();
    constexpr int TT = 24;
    for (int tile = bid_l(); tile < NBATCH * (TPB / TT); tile += gridDim.x) {
        const int b = tile / (TPB / TT), tau0 = (tile % (TPB / TT)) * TT;
        {
            u32x4 um[3];
#pragma unroll
            for (int q = 0; q < 3; ++q) { const int e = tid + q * NT, rr = e >> 5, part = e & 31; int tau = tau0 - 8 + rr; tau = tau < 0 ? 0 : (tau >= TPB ? TPB - 1 : tau);
                um[q] = *(const u32x4*)(z + ((size_t)b * TPB + tau) * ZW + Z_UM + part * 8); }
            __builtin_amdgcn_sched_barrier(0);
#pragma unroll
            for (int q = 0; q < 3; ++q) { const int e = tid + q * NT, rr = e >> 5, part = e & 31; if (e < (TT + 16) * 32) *(LAS u32x4*)(UM + rr * 256 + part * 8) = um[q]; }
        }
        u32x4 zreg[3][5];
#pragma unroll
        for (int q4 = 0; q4 < 3; ++q4) { const bf16_t* zg = z + ((size_t)b * TPB + tau0 + wave * 3 + q4) * ZW;
#pragma unroll
            for (int j = 0; j < 5; ++j) { const int ch = lane + 64 * j; if (ch < 304) zreg[q4][j] = *(const u32x4*)(zg + ch * 8); } }
#pragma unroll
        for (int q4 = 0; q4 < 3; ++q4) {
            const int tl = wave * 3 + q4, tau = tau0 + tl; const bool latent = tau >= CTXL;
#pragma unroll
            for (int j = 0; j < 5; ++j) { const int ch = lane + 64 * j; if (ch < 304) *(LAS u32x4*)(ZR + ch * 8) = zreg[q4][j]; }
            asm volatile("s_waitcnt lgkmcnt(0)" ::: "memory");
            const LAS bf16_t* zr = ZR;
            const int pos = latent ? tau - CTXL : 0, prow = pos >> 6, pcol = pos & 63;
            float sq = 0.f, skv = 0.f;
            { const u32x2 w = *(const LAS u32x2*)(zr + Z_QBA + 4 * lane); const float a0 = bflo(w.x), a1 = bfhi(w.x), a2 = bflo(w.y), a3 = bfhi(w.y); sq = (a0 * a0 + a1 * a1) + (a2 * a2 + a3 * a3);
              const unsigned v = *(const LAS unsigned*)(zr + Z_KVBA + 2 * lane); const float b0 = bflo(v), b1 = bfhi(v); skv = b0 * b0 + b1 * b1; }
            const float rq = rsqrtf(wave_sum(sq) * (1.0f / 256.0f) + EPS), rkv = rsqrtf(wave_sum(skv) * (1.0f / 128.0f) + EPS);
            head64(zr + Z_QA, 4, TAB + 3072, latent, cs64, prow, pcol, scA, Qa + ((size_t)(b * 4) * TPB + tau) * 64, (size_t)TPB * 64, lane);
            head64(zr + Z_KA, 2, TAB + 3136, latent, cs64, prow, pcol, 1.0f, Ka + ((size_t)(b * 2) * TPB + tau) * 64, (size_t)TPB * 64, lane);
            head64(zr + Z_QC, 4, nullptr, latent, cs64, prow, pcol, scA, Qc + ((size_t)(b * 4) * TPB + tau) * 64, (size_t)TPB * 64, lane);
            head64(zr + Z_KC, 2, nullptr, latent, cs64, prow, pcol, 1.0f, Kc + ((size_t)(b * 2) * TPB + tau) * 64, (size_t)TPB * 64, lane);
            {
                const int hh = lane >> 4, q = lane & 15;
                const int pp = q < 8 ? prow : pcol, f = q & 7;
                const float cc = latent ? cs32[pp * 8 + f] : 1.0f, sn = latent ? cs32[512 + pp * 8 + f] : 0.0f;
                bf16_t* qd = Qb + ((size_t)(b * 4 + hh) * TPB + tau) * 96; bf16_t* kd = Kb + ((size_t)(b * 4 + hh) * TPB + tau) * 96;
                { const u32x2 w = *(const LAS u32x2*)(zr + Z_QBF + hh * 96 + 4 * q); const float sN = rq * scB;
                  u32x2 o; o.x = pk2(bflo(w.x) * sN, bfhi(w.x) * sN); o.y = pk2(bflo(w.y) * sN, bfhi(w.y) * sN); *(u32x2*)(qd + 4 * q) = o;
                  const float x1 = bf2f(zr[Z_QBF + hh * 96 + 64 + q]) * sN, x2 = bf2f(zr[Z_QBF + hh * 96 + 80 + q]) * sN;
                  qd[64 + q] = (bf16_t)f2bf(x1 * cc - x2 * sn); qd[80 + q] = (bf16_t)f2bf(x1 * sn + x2 * cc); }
                { const u32x2 w = *(const LAS u32x2*)(zr + Z_KVBF + hh * 128 + 4 * q);
                  u32x2 o; o.x = pk2(bflo(w.x) * rkv, bfhi(w.x) * rkv); o.y = pk2(bflo(w.y) * rkv, bfhi(w.y) * rkv); *(u32x2*)(kd + 4 * q) = o;
                  const float x1 = bf2f(zr[Z_KBR + q]), x2 = bf2f(zr[Z_KBR + 16 + q]);
                  kd[64 + q] = (bf16_t)f2bf(x1 * cc - x2 * sn); kd[80 + q] = (bf16_t)f2bf(x1 * sn + x2 * cc); }
            }
#pragma unroll
            for (int j = 0; j < 2; ++j) { const int col = lane + 64 * j; VT[col * 40 + tl] = zr[Z_VA + col]; VT[(128 + col) * 40 + tl] = zr[Z_VC + col]; }
#pragma unroll
            for (int j = 0; j < 4; ++j) { const int ci = lane + 64 * j, hd = ci >> 6, dv = ci & 63; VT[(256 + ci) * 40 + tl] = (bf16_t)f2bf(bf2f(zr[Z_KVBF + hd * 128 + 64 + dv]) * rkv); }
            asm volatile("s_waitcnt lgkmcnt(0)" ::: "memory");
        }
        __syncthreads();
        {
            const int col = tid; bf16_t* dst;
            if (col < 128) dst = VaT + ((size_t)(b * 2 + (col >> 6)) * 64 + (col & 63)) * TPB + tau0;
            else if (col < 256) { const int c2 = col - 128; dst = VcT + ((size_t)(b * 2 + (c2 >> 6)) * 64 + (c2 & 63)) * TPB + tau0; }
            else { const int c2 = col - 256; dst = VbT + ((size_t)(b * 4 + (c2 >> 6)) * 64 + (c2 & 63)) * TPB + tau0; }
#pragma unroll
            for (int qd = 0; qd < 6; ++qd) { const int k = tau0 + 4 * qd, g = (k >> 2) & 3, pq = (g == 1) ? 2 : ((g == 2) ? 1 : g);
                *(u32x2*)(dst - tau0 + (k & ~15) + 4 * pq) = *(const LAS u32x2*)(VT + col * 40 + 4 * qd); }
        }
        {
            const int c = tid & 255, half = tid >> 8, g = c >> 6, win = 2 << g, lo = win >> 1, hi = win - lo - 1;
            for (int t = 0; t < TT / 2; ++t) {
                const int tau = tau0 + half * (TT / 2) + t;
                const int s0 = tau >= CTXL ? CTXL : 0, s1 = tau >= CTXL ? TPB : CTXL;
                const int st = max(tau - lo, s0), en = min(tau + hi + 1, s1);
                float sum = 0.f;
                for (int j = st; j < en; ++j) sum += bf2f(UM[(j - tau0 + 8) * 256 + c]);
                const float own = bf2f(UM[(tau - tau0 + 8) * 256 + c]);
                Ocat[((size_t)b * TPB + tau) * DM + 768 + c] = (bf16_t)f2bf(sum / (float)(en - st) - own);
            }
        }
        __syncthreads();
    }
}

struct AttnJob {
    const bf16_t* Q;
    const bf16_t* K;
    const bf16_t* VT;
    bf16_t* O;
    int nt0, t1lo, t1hi;
    int qtau0;
    int mask;
    float sink; int has_sink;
};
template <int DQK>
__device__ __forceinline__ void attn_unit(const AttnJob& J, LAS unsigned char* lds) {
    constexpr int KSTR = DQK + 8, VSTR = 72, NKK = DQK / 16;
    constexpr int KBYTES = 64 * KSTR * 2, VBYTES = 64 * VSTR * 2;
    constexpr int KCH = DQK / 8;
    const int tid = tid_l(), lane = tid & 63, r = lane & 31, h = lane >> 5;
    LAS unsigned char* Kbuf = lds; LAS unsigned char* Vbuf = lds + 2 * KBYTES;
    bf16x8 qf[NKK];
#pragma unroll
    for (int kk = 0; kk < NKK; ++kk) qf[kk] = *(const bf16x8*)(J.Q + (size_t)r * DQK + kk * 16 + h * 8);
    const int ntiles = J.nt0 + (J.t1hi - J.t1lo);
    const int k0key = tid / KCH, k0part = tid % KCH;
    const int k1 = tid + 512, k1key = k1 / KCH, k1part = k1 % KCH;
    const bool has_k1 = (DQK == 96) && (tid < 256);
    const int vdv = tid >> 3, vpart = tid & 7;
    u32x4 kx0, kx1 = (u32x4){0u, 0u, 0u, 0u}, vx, ky0, ky1 = (u32x4){0u, 0u, 0u, 0u}, vy;
    auto tile_of = [&](int i) { return i < J.nt0 ? i : J.t1lo + (i - J.nt0); };
    auto gloadK = [&](int ti, u32x4& r0, u32x4& r1) {
        const bf16_t* kp = J.K + (size_t)ti * 64 * DQK;
        r0 = *(const u32x4*)(kp + k0key * DQK + k0part * 8);
        if (has_k1) r1 = *(const u32x4*)(kp + k1key * DQK + k1part * 8);
    };
    auto gloadV = [&](int ti, u32x4& rv) { rv = *(const u32x4*)(J.VT + (size_t)vdv * TPB + ti * 64 + vpart * 8); };
    auto lstoreK = [&](int buf, const u32x4& r0, const u32x4& r1) {
        *(LAS u32x4*)(Kbuf + buf * KBYTES + (k0key * KSTR + k0part * 8) * 2) = r0;
        if (has_k1) *(LAS u32x4*)(Kbuf + buf * KBYTES + (k1key * KSTR + k1part * 8) * 2) = r1;
    };
    auto lstoreV = [&](int buf, const u32x4& rv) { *(LAS u32x4*)(Vbuf + buf * VBYTES + (vdv * VSTR + vpart * 8) * 2) = rv; };
    f32x16 negm;
#pragma unroll
    for (int i = 0; i < 16; ++i) negm[i] = 0.f;
    auto qk = [&](f32x16& x0, f32x16& x1, int slot) {
        const LAS unsigned char* Kb = Kbuf + slot * KBYTES;
        bf16x8 ka[NKK][2];
#pragma unroll
        for (int kk = 0; kk < NKK; ++kk) {
            ka[kk][0] = *(const LAS bf16x8*)(Kb + (r * KSTR + kk * 16 + h * 8) * 2);
            ka[kk][1] = *(const LAS bf16x8*)(Kb + ((32 + r) * KSTR + kk * 16 + h * 8) * 2);
        }
        __builtin_amdgcn_sched_barrier(0);
#pragma unroll
        for (int kk = 0; kk < NKK; ++kk) {
            if (kk == 0) { x0 = __builtin_amdgcn_mfma_f32_32x32x16_bf16(ka[kk][0], qf[kk], negm, 0, 0, 0); x1 = __builtin_amdgcn_mfma_f32_32x32x16_bf16(ka[kk][1], qf[kk], negm, 0, 0, 0); }
            else { x0 = __builtin_amdgcn_mfma_f32_32x32x16_bf16(ka[kk][0], qf[kk], x0, 0, 0, 0); x1 = __builtin_amdgcn_mfma_f32_32x32x16_bf16(ka[kk][1], qf[kk], x1, 0, 0, 0); }
        }
    };
    f32x16 o0, o1;
#pragma unroll
    for (int i = 0; i < 16; ++i) { o0[i] = 0.f; o1[i] = 0.f; }
    float lrun = 0.f;
    const int qtau = J.qtau0 + r;
    auto step = [&](int it, f32x16& sc0, f32x16& sc1, f32x16& sn0, f32x16& sn1, u32x4& lk0, u32x4& lk1, u32x4& lv, const u32x4& sk0, const u32x4& sk1, const u32x4& sv) {
        const bool more1 = it + 1 < ntiles, more2 = it + 2 < ntiles;
        if (it + 3 < ntiles) gloadK(tile_of(it + 3), lk0, lk1);
        if (more2) gloadV(tile_of(it + 2), lv);
        if (more1) qk(sn0, sn1, (it + 1) & 1);
        const int ti = tile_of(it);
        const LAS unsigned char* Vb = Vbuf + (it & 1) * VBYTES;
        u32x4 vf[4][2];
#pragma unroll
        for (int kq = 0; kq < 4; ++kq) {
            const int koff = (kq >> 1) * 32 + 16 * (kq & 1) + 8 * h;
            vf[kq][0] = *(const LAS u32x4*)(Vb + (r * VSTR + koff) * 2);
            vf[kq][1] = *(const LAS u32x4*)(Vb + ((32 + r) * VSTR + koff) * 2);
        }
        __builtin_amdgcn_sched_barrier(0);
        if (J.mask && it >= J.nt0) {
            const int kb0 = ti * 64 + 4 * h - qtau;
#pragma unroll
            for (int i = 0; i < 16; ++i) {
                const int d0 = kb0 + (i & 3) + 8 * (i >> 2), d1 = d0 + 32;
                if (d0 > 128 || d0 < -128) sc0[i] = -1e30f;
                if (d1 > 128 || d1 < -128) sc1[i] = -1e30f;
            }
        }
        float mx = sc0[0];
#pragma unroll
        for (int i = 1; i < 16; ++i) mx = fmaxf(mx, sc0[i]);
#pragma unroll
        for (int i = 0; i < 16; ++i) mx = fmaxf(mx, sc1[i]);
        mx = xhalf_max(mx);
        if (it == 0 || __any(mx > 8.0f)) {
            const float delta = (it == 0) ? mx : fmaxf(mx, 0.f);
            const float alpha = __builtin_amdgcn_exp2f(-delta);
            lrun *= alpha;
#pragma unroll
            for (int i = 0; i < 16; ++i) { o0[i] *= alpha; o1[i] *= alpha; sc0[i] -= delta; sc1[i] -= delta; negm[i] -= delta; }
            if (more1) {
#pragma unroll
                for (int i = 0; i < 16; ++i) { sn0[i] -= delta; sn1[i] -= delta; }
            }
        }
        float ls = 0.f;
#pragma unroll
        for (int i = 0; i < 16; ++i) { sc0[i] = __builtin_amdgcn_exp2f(sc0[i]); sc1[i] = __builtin_amdgcn_exp2f(sc1[i]); ls += sc0[i] + sc1[i]; }
        lrun += ls;
        bf16x8 pf[2][2];
#pragma unroll
        for (int sp = 0; sp < 2; ++sp) {
            u32x4 w0, w1;
            w0.x = cvt_pk_bf16(sc0[8 * sp + 0], sc0[8 * sp + 1]); w0.y = cvt_pk_bf16(sc0[8 * sp + 2], sc0[8 * sp + 3]); w0.z = cvt_pk_bf16(sc0[8 * sp + 4], sc0[8 * sp + 5]); w0.w = cvt_pk_bf16(sc0[8 * sp + 6], sc0[8 * sp + 7]);
            w1.x = cvt_pk_bf16(sc1[8 * sp + 0], sc1[8 * sp + 1]); w1.y = cvt_pk_bf16(sc1[8 * sp + 2], sc1[8 * sp + 3]); w1.z = cvt_pk_bf16(sc1[8 * sp + 4], sc1[8 * sp + 5]); w1.w = cvt_pk_bf16(sc1[8 * sp + 6], sc1[8 * sp + 7]);
            pf[0][sp] = __builtin_bit_cast(bf16x8, w0); pf[1][sp] = __builtin_bit_cast(bf16x8, w1);
        }
#pragma unroll
        for (int kb = 0; kb < 2; ++kb)
#pragma unroll
            for (int sp = 0; sp < 2; ++sp) {
                o0 = __builtin_amdgcn_mfma_f32_32x32x16_bf16(__builtin_bit_cast(bf16x8, vf[kb * 2 + sp][0]), pf[kb][sp], o0, 0, 0, 0);
                o1 = __builtin_amdgcn_mfma_f32_32x32x16_bf16(__builtin_bit_cast(bf16x8, vf[kb * 2 + sp][1]), pf[kb][sp], o1, 0, 0, 0);
            }
        if (more2) lstoreK(it & 1, sk0, sk1);
        if (more1) lstoreV((it + 1) & 1, sv);
        __syncthreads();
    };
    u32x4 kb0, kb1 = (u32x4){0u, 0u, 0u, 0u};
    gloadK(tile_of(0), kx0, kx1); gloadV(tile_of(0), vx); gloadK(tile_of(1), kb0, kb1);
    __syncthreads();
    lstoreK(0, kx0, kx1); lstoreV(0, vx); lstoreK(1, kb0, kb1);
    gloadK(tile_of(2), kx0, kx1); gloadV(tile_of(1), vx);
    __syncthreads();
    f32x16 sA0, sA1, sB0, sB1;
    qk(sA0, sA1, 0);
    __syncthreads();
#pragma unroll 1
    for (int it = 0; it < ntiles; it += 2) {
        step(it, sA0, sA1, sB0, sB1, ky0, ky1, vy, kx0, kx1, vx);
        if (it + 1 < ntiles) step(it + 1, sB0, sB1, sA0, sA1, kx0, kx1, vx, ky0, ky1, vy);
    }
    float ltot = xhalf_sum(lrun);
    if (J.has_sink) ltot += __builtin_amdgcn_exp2f(J.sink + negm[0]);
    const float inv = 1.0f / ltot;
    bf16_t* orow = J.O + (size_t)r * DM;
#pragma unroll
    for (int g = 0; g < 4; ++g) {
        u32x2 w; w.x = cvt_pk_bf16(o0[4 * g] * inv, o0[4 * g + 1] * inv); w.y = cvt_pk_bf16(o0[4 * g + 2] * inv, o0[4 * g + 3] * inv);
        *(u32x2*)(orow + 8 * g + 4 * h) = w;
        u32x2 w2; w2.x = cvt_pk_bf16(o1[4 * g] * inv, o1[4 * g + 1] * inv); w2.y = cvt_pk_bf16(o1[4 * g + 2] * inv, o1[4 * g + 3] * inv);
        *(u32x2*)(orow + 32 + 8 * g + 4 * h) = w2;
    }
}
__device__ __forceinline__ void attn_phase(CPARAMS p, unsigned char* ws_, int l, LAS unsigned char* lds) {
    const int wave = __builtin_amdgcn_readfirstlane(tid_l() >> 6);
    unsigned char* at = ws_ + WS_B;
    const bf16_t *Qa = (const bf16_t*)(at + AT_QA), *Ka = (const bf16_t*)(at + AT_KA), *VaT = (const bf16_t*)(at + AT_VAT), *Qc = (const bf16_t*)(at + AT_QC), *Kc = (const bf16_t*)(at + AT_KC), *VcT = (const bf16_t*)(at + AT_VCT);
    const bf16_t *Qb = (const bf16_t*)(at + AT_QB), *Kb = (const bf16_t*)(at + AT_KB), *VbT = (const bf16_t*)(at + AT_VBT);
    bf16_t* Ocat = (bf16_t*)(ws_ + WS_O);
    const int G_ = gridDim.x, c_ = bid_l(), vcu = (G_ % 8 == 0) ? (c_ % 8) * (G_ / 8) + c_ / 8 : c_;
    for (int u = vcu; u < (l == DEPTH - 1 ? 768 : 864); u += G_) {
        AttnJob J; J.mask = 0; J.has_sink = 0; J.sink = 0.f; J.t1lo = 0; J.t1hi = 0;
        int kind, b, hk, qb, lat;
        if (u < 256) { kind = 0; lat = 1; b = u / 32; hk = (u % 32) / 16; qb = u % 16; }
        else if (u < 512) { const int v = u - 256; kind = 1; lat = 1; b = v / 32; hk = (v % 32) / 8; qb = v % 8; }
        else if (u < 768) { const int v = u - 512; kind = 2; lat = 1; b = v / 32; hk = (v % 32) / 16; qb = v % 16; }
        else if (u < 800) { const int v = u - 768; kind = 0; lat = 0; b = v / 4; hk = (v % 4) / 2; qb = v % 2; }
        else if (u < 832) { const int v = u - 800; kind = 1; lat = 0; b = v / 4; hk = v % 4; qb = 0; }
        else { const int v = u - 832; kind = 2; lat = 0; b = v / 4; hk = (v % 4) / 2; qb = v % 2; }
        J.nt0 = lat ? 36 : 4;
        if (kind == 1) {
            const int head = hk, tau0 = (lat ? CTXL : 0) + qb * 256 + wave * 32;
            J.Q = Qb + ((size_t)(b * 4 + head) * TPB + tau0) * 96; J.K = Kb + (size_t)(b * 4 + head) * TPB * 96; J.VT = VbT + (size_t)(b * 4 + head) * 64 * TPB;
            J.O = Ocat + ((size_t)b * TPB + tau0) * DM + 256 + head * 64; J.qtau0 = tau0;
            attn_unit<96>(J, lds);
        } else {
            const int head = hk * 2 + (wave >> 2), tau0 = (lat ? CTXL : 0) + qb * 128 + (wave & 3) * 32;
            const bf16_t *Qx = kind == 0 ? Qa : Qc, *Kx = kind == 0 ? Ka : Kc, *Vx = kind == 0 ? VaT : VcT;
            J.Q = Qx + ((size_t)(b * 4 + head) * TPB + tau0) * 64; J.K = Kx + (size_t)(b * 2 + hk) * TPB * 64; J.VT = Vx + (size_t)(b * 2 + hk) * 64 * TPB;
            J.O = Ocat + ((size_t)b * TPB + tau0) * DM + (kind == 0 ? 0 : 512) + head * 64; J.qtau0 = tau0;
            if (kind == 2) {
                J.has_sink = 1; J.sink = p.c_sink[l * 4 + head] * LOG2E;
                if (lat) { J.nt0 = 4; J.t1lo = max(2 * qb + 2, 4); J.t1hi = min(2 * qb + 8, 36); J.mask = 1; }
            }
            attn_unit<64>(J, lds);
        }
    }
    __syncthreads();
}

__device__ __forceinline__ void merge_phase(CPARAMS p, unsigned char* ws_, LAS unsigned char* lds, int skip) {
    constexpr int STR = 136;
    constexpr int TILEB = 128 * STR * 2, STAGEB = 2 * TILEB;
    const int tid = tid_l(), lane = tid & 63, wave = __builtin_amdgcn_readfirstlane(tid >> 6), r = lane & 31, h = lane >> 5;
    const int wt = wave & 3, wd = wave >> 2;
    const bf16_t* Ocat = (const bf16_t*)(ws_ + WS_O); const bf16_t* Wbt = (const bf16_t*)(ws_ + WS_WBT);
    const bf16_t* gates = (const bf16_t*)(ws_ + WS_A); const bf16_t* gearly = (const bf16_t*)(ws_ + WS_GE); bf16_t* merged = (bf16_t*)(ws_ + WS_H);
    const int G_ = gridDim.x, c_ = bid_l(), vcu = (G_ % 8 == 0) ? (c_ % 8) * (G_ / 8) + c_ / 8 : c_;
    const unsigned off0 = (unsigned)(((tid >> 4) * DM + (tid & 15) * 8) * 2);
    LAS unsigned char* ost = lds + ((tid >> 4) * STR + (tid & 15) * 8) * 2;
    for (int u = vcu; u < (skip ? 128 : 144) * 8; u += G_) {
        int tm = u >> 3; if (skip) tm = tm + (tm >> 4) * 2 + 2;
        const int tn = u & 7, t0 = tm * 128, d0 = tn * 128;
        f32x16 mg0, mg1, p0, p1;
#pragma unroll
        for (int i = 0; i < 16; ++i) { mg0[i] = 0.f; mg1[i] = 0.f; p0[i] = 0.f; p1[i] = 0.f; }
        const size_t trow = (size_t)(t0 + wt * 32 + r);
        const char* obase = (const char*)(Ocat + (size_t)t0 * DM); const char* wbase = (const char*)(Wbt + (size_t)d0 * DM);
        u32x4 ro[3][4], rw[3][4];
#define MERGE_LOADS(kc_) do { _Pragma("unroll") for (int e4 = 0; e4 < 4; ++e4) { \
            ro[(kc_) % 3][e4] = *(const u32x4*)(obase + (kc_) * 256 + (off0 + (unsigned)e4 * 65536u)); rw[(kc_) % 3][e4] = *(const u32x4*)(wbase + (kc_) * 256 + (off0 + (unsigned)e4 * 65536u)); } } while (0)
#define MERGE_STORES(kc_) do { _Pragma("unroll") for (int e4 = 0; e4 < 4; ++e4) { \
            *(LAS u32x4*)(ost + ((kc_) & 1) * STAGEB + e4 * (32 * STR * 2)) = ro[(kc_) % 3][e4]; *(LAS u32x4*)(ost + ((kc_) & 1) * STAGEB + TILEB + e4 * (32 * STR * 2)) = rw[(kc_) % 3][e4]; } } while (0)
        MERGE_LOADS(0); MERGE_LOADS(1); MERGE_LOADS(2);
        __syncthreads();
        MERGE_STORES(0);
        __syncthreads();
        u32x2 ga[4], gb[4];
#pragma unroll
        for (int kc = 0; kc < 8; ++kc) {
            const int kb = kc >> 1;
            if ((kc & 1) == 0) {
                const bf16_t* grow = (kb == 0 && d0 < GE) ? gearly + trow * GE + d0 + wd * 64 + 32 * h : gates + trow * GW + kb * 1024 + d0 + wd * 64 + 32 * h;
                { const u32x4 q0 = ((const u32x4*)grow)[0], q1 = ((const u32x4*)grow)[1], q2 = ((const u32x4*)grow)[2], q3 = ((const u32x4*)grow)[3];
                  ga[0] = (u32x2){q0.x, q0.y}; ga[1] = (u32x2){q0.z, q0.w}; ga[2] = (u32x2){q1.x, q1.y}; ga[3] = (u32x2){q1.z, q1.w};
                  gb[0] = (u32x2){q2.x, q2.y}; gb[1] = (u32x2){q2.z, q2.w}; gb[2] = (u32x2){q3.x, q3.y}; gb[3] = (u32x2){q3.z, q3.w}; }
            }
            if (kc + 1 < 8) MERGE_STORES(kc + 1);
            if (kc + 3 < 8) MERGE_LOADS(kc + 3);
            const LAS bf16_t* Ot = (const LAS bf16_t*)(lds + (kc & 1) * STAGEB); const LAS bf16_t* Wt = (const LAS bf16_t*)(lds + (kc & 1) * STAGEB + TILEB);
#pragma unroll
            for (int kh = 0; kh < 4; ++kh) {
                bf16x8 fb[2], fa0[2], fa1[2];
#pragma unroll
                for (int k4 = 0; k4 < 2; ++k4) {
                    const int ks = kh * 2 + k4;
                    fb[k4] = *(const LAS bf16x8*)(Ot + (wt * 32 + r) * STR + ks * 16 + h * 8);
                    fa0[k4] = *(const LAS bf16x8*)(Wt + (wd * 64 + r) * STR + ks * 16 + h * 8);
                    fa1[k4] = *(const LAS bf16x8*)(Wt + (wd * 64 + 32 + r) * STR + ks * 16 + h * 8);
                }
                __builtin_amdgcn_sched_barrier(0);
#pragma unroll
                for (int k4 = 0; k4 < 2; ++k4) {
                    p0 = __builtin_amdgcn_mfma_f32_32x32x16_bf16(fa0[k4], fb[k4], p0, 0, 0, 0);
                    p1 = __builtin_amdgcn_mfma_f32_32x32x16_bf16(fa1[k4], fb[k4], p1, 0, 0, 0);
                }
            }
            if (kc & 1) {
#pragma unroll
                for (int g = 0; g < 4; ++g) {
                    mg0[4 * g] += bflo(ga[g].x) * p0[4 * g]; mg0[4 * g + 1] += bfhi(ga[g].x) * p0[4 * g + 1]; mg0[4 * g + 2] += bflo(ga[g].y) * p0[4 * g + 2]; mg0[4 * g + 3] += bfhi(ga[g].y) * p0[4 * g + 3];
                    mg1[4 * g] += bflo(gb[g].x) * p1[4 * g]; mg1[4 * g + 1] += bfhi(gb[g].x) * p1[4 * g + 1]; mg1[4 * g + 2] += bflo(gb[g].y) * p1[4 * g + 2]; mg1[4 * g + 3] += bfhi(gb[g].y) * p1[4 * g + 3];
                }
#pragma unroll
                for (int i = 0; i < 16; ++i) { p0[i] = 0.f; p1[i] = 0.f; }
            }
            __syncthreads();
        }
#undef MERGE_LOADS
#undef MERGE_STORES
        bf16_t* mrow = merged + trow * DM + d0 + wd * 64 + 32 * h;
#pragma unroll
        for (int q = 0; q < 2; ++q) {
            u32x4 w; w.x = cvt_pk_bf16(mg0[8 * q], mg0[8 * q + 1]); w.y = cvt_pk_bf16(mg0[8 * q + 2], mg0[8 * q + 3]); w.z = cvt_pk_bf16(mg0[8 * q + 4], mg0[8 * q + 5]); w.w = cvt_pk_bf16(mg0[8 * q + 6], mg0[8 * q + 7]);
            ((u32x4*)mrow)[q] = w;
            u32x4 w2; w2.x = cvt_pk_bf16(mg1[8 * q], mg1[8 * q + 1]); w2.y = cvt_pk_bf16(mg1[8 * q + 2], mg1[8 * q + 3]); w2.z = cvt_pk_bf16(mg1[8 * q + 4], mg1[8 * q + 5]); w2.w = cvt_pk_bf16(mg1[8 * q + 6], mg1[8 * q + 7]);
            ((u32x4*)mrow)[2 + q] = w2;
        }
    }
    __syncthreads();
}

#define XB_TMO      128
#define XB_XCNT(j)  (256  + 64 * (j))
#define XB_XSUB(j)  (1280 + 64 * (j))
#define XB_XGEN(j)  (2304 + 64 * (j))
#define XB_TOP      3328
#define XB_TOPGEN   3392
#define XCD_BAR_WORDS 3456
#define XB_SPIN_CAP (1u << 20)
__device__ __forceinline__ unsigned xb_ld(unsigned* p)              { return __hip_atomic_load(p, __ATOMIC_RELAXED, __HIP_MEMORY_SCOPE_AGENT); }
__device__ __forceinline__ unsigned xb_add(unsigned* p, unsigned v) { return __hip_atomic_fetch_add(p, v, __ATOMIC_RELAXED, __HIP_MEMORY_SCOPE_AGENT); }
__device__ __forceinline__ unsigned xb_xcc_id() { return (unsigned)__builtin_amdgcn_s_getreg((3 << 11) | 20) & 0xFu; }
#define XB_SPIN(cond, bar) do { unsigned _sp = 0; while (cond) { __builtin_amdgcn_s_sleep(1); \
    if ((++_sp & 255u) == 0u) { if (xb_ld(&(bar)[XB_TMO])) break; if (_sp > XB_SPIN_CAP) { atomicAdd(&(bar)[XB_TMO], 1u); break; } } } } while (0)
struct XcdBarrier { unsigned* bar; unsigned x; volatile LAS unsigned* st; };
__device__ __forceinline__ XcdBarrier xcd_barrier_post(unsigned* bar, volatile LAS unsigned* st) {
    XcdBarrier b; b.bar = bar; b.x = xb_xcc_id(); b.st = st;
    if (threadIdx.x == 0) (void)xb_add(&bar[XB_XCNT(b.x)], 1u);
    return b;
}
__device__ __forceinline__ void xcd_barrier_complete(unsigned* bar, unsigned x, unsigned& nloc, unsigned& nx) {
    const unsigned G = gridDim.x * gridDim.y * gridDim.z;
    unsigned sum, cnt, mine, sp = 0u;
    for (;;) {
        sum = 0u; cnt = 0u; mine = 0u;
#pragma unroll
        for (unsigned j = 0; j < 16; ++j) { const unsigned c = xb_ld(&bar[XB_XCNT(j)]); sum += c; cnt += (c > 0u) ? 1u : 0u; mine = (j == x) ? c : mine; }
        if (sum == G) break;
        __builtin_amdgcn_s_sleep(1);
        if ((++sp & 255u) == 0u) { if (xb_ld(&bar[XB_TMO])) break; if (sp > XB_SPIN_CAP) { atomicAdd(&bar[XB_TMO], 1u); break; } }
    }
    nloc = mine > 0u ? mine : 1u; nx = cnt > 0u ? cnt : 1u;
}
__device__ __forceinline__ void xcd_barrier(const XcdBarrier& b) {
    asm volatile("s_waitcnt vmcnt(0)" ::: "memory");
    __syncthreads();
    if (threadIdx.x == 0) {
        unsigned* bar = b.bar;
        __builtin_amdgcn_s_waitcnt(0);
        unsigned nloc = b.st[0], nx = b.st[1];
        if (nloc == 0u) { xcd_barrier_complete(bar, b.x, nloc, nx); b.st[0] = nloc; b.st[1] = nx; }
        const unsigned old = xb_add(&bar[XB_XSUB(b.x)], 1u);
        const unsigned gen = old / nloc;
        if (old + 1u == (gen + 1u) * nloc) {
            __builtin_amdgcn_fence(__ATOMIC_RELEASE, "agent");
            asm volatile("s_waitcnt vmcnt(0)" ::: "memory");
            const unsigned og = xb_add(&bar[XB_TOP], 1u);
            const unsigned tg = og / nx;
            if (og + 1u == (tg + 1u) * nx) xb_add(&bar[XB_TOPGEN], 1u);
            else XB_SPIN(xb_ld(&bar[XB_TOPGEN]) == tg, bar);
            __builtin_amdgcn_fence(__ATOMIC_ACQUIRE, "agent");
            xb_add(&bar[XB_XGEN(b.x)], 1u);
            asm volatile("s_waitcnt vmcnt(0)" ::: "memory");
        } else {
            XB_SPIN(xb_ld(&bar[XB_XGEN(b.x)]) == gen, bar);
            __builtin_amdgcn_fence(__ATOMIC_ACQUIRE, "agent");
            asm volatile("s_waitcnt vmcnt(0)" ::: "memory");
        }
    }
    __syncthreads();
}

constexpr int NPH = 3 + 9 * DEPTH;
__device__ __forceinline__ void run_phase(CPARAMS p, unsigned char* ws_, int ph, LAS unsigned char* lds) {
    const int G = gridDim.x, c = bid_l();
#ifndef ONLY
#define ONLY -1
#endif
#ifndef RP_ROW
#define RP_ROW 1
#endif
#ifndef RP_SYNC
#define RP_SYNC 1
#endif
#ifndef RP_P0
#define RP_P0 1
#endif
#ifndef RP_ATT
#define RP_ATT 1
#endif
#ifndef RP_GP
#define RP_GP 1
#endif
#ifndef RP_GF
#define RP_GF 1
#endif
#ifndef RP_PREP
#define RP_PREP 1
#endif
#ifndef RP_MERGE
#define RP_MERGE 1
#endif
#ifndef RP_PW
#define RP_PW 1
#endif
#ifndef ONLY2
#define ONLY2 -2
#endif
#ifndef ONLY3
#define ONLY3 -2
#endif
#define EN(id) (ONLY < 0 || ONLY == (id) || ONLY2 == (id) || ONLY3 == (id))
    if (ph == 0) { if (EN(100)) mod_partial_phase(p, ws_, lds); if (EN(101)) rope_table_phase(p, ws_); if (EN(102)) for (int rp = 0; rp < RP_PW; ++rp) prep_weights(p, ws_, 0, lds, 1 | 4, bid_l(), gridDim.x); return; }
    if (ph == 1) { if (EN(103)) mod_reduce_phase(p, ws_); return; }
    if (ph == 2) { if (EN(104)) row_phase<0>(p, ws_, 0, 0); return; }
    const int l = (ph - 3) / 9, s = (ph - 3) % 9;
    if (s == 1) { if (EN(1)) for (int rp = 0; rp < RP_PREP; ++rp) prep_phase(p, ws_, l, lds); return; }
    if (s == 3) { if (EN(3)) for (int rp = 0; rp < RP_MERGE; ++rp) merge_phase(p, ws_, lds, l == DEPTH - 1 ? 1 : 0); return; }
    if (s == 5) { if (EN(5)) row_phase<1>(p, ws_, l, (l < DEPTH - 1 && gridDim.x == 256) ? 4 : 0); return; }
    if (s == 8) { if (EN(8)) row_phase<2>(p, ws_, l, 0); return; }
    if (s == 2) { if (EN(2)) for (int rp = 0; rp < RP_ATT; ++rp) attn_phase(p, ws_, l, lds); }
    {
        if (EN(0)) {
        const bool n1k = (s == 4 || s == 7);
        const bf16_t* A = (const bf16_t*)(ws_ + (s == 7 ? WS_A : WS_H));
        const bf16_t* Bt = s == 4 ? (const bf16_t*)(ws_ + WS_WO) : s == 7 ? (const bf16_t*)(ws_ + WS_W2) : (const bf16_t*)(ws_ + (s == 6 ? WS_W13 : WS_WCAT)) + (s == 2 ? (size_t)(ZW + GE) * DM : (size_t)0);
        const int N = n1k ? DM : (s == 0 ? ZW + GE : (s == 2 ? GW - GE : 2 * DFF));
        const int K = s == 7 ? DFF : DM;
        const int split = (s == 4 && l < DEPTH - 1 && G == 256) ? 1 : 0;
        pg8::Gemm g{A, Bt, MROWS, N, K}; pg8::StaticOrder S; S.init(MROWS, N, K, G, c, (l == DEPTH - 1 && s != 0) ? 1 : 0, split);
        bf16_t* O = n1k ? (bf16_t*)(ws_ + WS_B) : (bf16_t*)(ws_ + WS_A) + (s == 2 ? GE : 0);
        const int ldc = n1k ? DM : (s == 0 ? ZW : (s == 2 ? GW : DFF));
        const int mode = n1k ? 0 : (s == 0 ? 0 : (s == 2 ? 1 : 2));
        pg8::EpiP E{O, ldc, mode, s == 0 ? ZW / 256 : 1 << 20, (bf16_t*)(ws_ + WS_GE), GE, 1, (bf16_t*)(ws_ + WS_O)};
        for (int rp = 0; rp < ((n1k ? RP_GF : RP_GP)); ++rp) pg8::gemm_phase<pg8::EpiP, pg8::StaticOrder>(lds, g, S, E);
        const int nfull = S.nwg % G;
        if (c >= nfull) {
            if (s == 0 && l == 0) for (int rp = 0; rp < RP_PW; ++rp) prep_weights(p, ws_, 0, lds, 2, c - nfull, G - nfull);
            if (s == 6) for (int rp = 0; rp < RP_PW; ++rp) prep_weights(p, ws_, l, lds, 8, c - nfull, G - nfull);
            if (s == 6 && l + 1 < DEPTH) for (int rp = 0; rp < RP_PW; ++rp) prep_weights(p, ws_, l + 1, lds, 2, c - nfull, G - nfull);
            if (s == 7 && l + 1 < DEPTH) for (int rp = 0; rp < RP_PW; ++rp) prep_weights(p, ws_, l + 1, lds, 1 | 4, c - nfull, G - nfull);
        }
        }
    }
}

__global__ void __launch_bounds__(NT, 2) fwd_kernel(Params p) {
    extern __shared__ __attribute__((aligned(16))) unsigned char lds_raw[];
    LAS unsigned char* lds = (LAS unsigned char*)lds_raw;
    volatile LAS unsigned* st = (volatile LAS unsigned*)(lds + LDS_BYTES - 64);
    if (threadIdx.x < 16) st[threadIdx.x] = 0u;
    __syncthreads();
    XcdBarrier gbar = xcd_barrier_post((unsigned*)(p.ws + WS_BAR), st);
    for (int rp0 = 1; rp0 < RP_P0; ++rp0) for (int ph = 0; ph < 3; ++ph) {
        const __attribute__((address_space(4))) char* ka0 = (const __attribute__((address_space(4))) char*)__builtin_amdgcn_kernarg_segment_ptr();
        asm volatile("" : "+s"(ka0));
        CPARAMS P0 = *(const __attribute__((address_space(4))) Params*)ka0;
        run_phase(P0, P0.ws, ph, lds);
        { XcdBarrier gb2 = gbar; asm volatile("" : "+s"(gb2.bar)); asm volatile("" : "+s"(gb2.x)); xcd_barrier(gb2); }
    }
    for (int ph = p.ph_lo; ph < p.ph_hi; ++ph) {
        const __attribute__((address_space(4))) char* ka = (const __attribute__((address_space(4))) char*)__builtin_amdgcn_kernarg_segment_ptr();
        asm volatile("" : "+s"(ka));
        CPARAMS P = *(const __attribute__((address_space(4))) Params*)ka;
        unsigned char* ws_ = P.ws;
        run_phase(P, ws_, ph, lds);
        if (ph + 1 < p.ph_hi) { if (p.ph_hi < 0) cg::this_grid().sync(); else for (int rs = 0; rs < RP_SYNC; ++rs) { XcdBarrier gb2 = gbar; asm volatile("" : "+s"(gb2.bar)); asm volatile("" : "+s"(gb2.x)); xcd_barrier(gb2); } }
    }
}

extern "C" void kernel_launch(void* const* d_in, const int* in_sizes, int n_in, void* d_out, int out_size, void* d_ws, size_t ws_size, hipStream_t stream) {
    static int grid = 0;
    if (grid == 0) {
        int dev = 0, cus = 0, per_cu = 0;
        hipGetDevice(&dev);
        hipDeviceGetAttribute(&cus, hipDeviceAttributeMultiprocessorCount, dev);
        hipFuncSetAttribute((const void*)fwd_kernel, hipFuncAttributeMaxDynamicSharedMemorySize, LDS_BYTES);
        hipOccupancyMaxActiveBlocksPerMultiprocessor(&per_cu, (const void*)fwd_kernel, NT, LDS_BYTES);
        if (per_cu < 1) { fprintf(stderr, "kernel_launch: occupancy query says %d blocks/CU\n", per_cu); per_cu = 1; }
        (void)hipGetLastError();
        grid = cus * per_cu;
        if (ws_size < WS_END) fprintf(stderr, "kernel_launch: workspace too small: %zu < %zu\n", ws_size, (size_t)WS_END);
    }
    (void)hipMemsetAsync((char*)d_ws + WS_BAR, 0, BAR_BYTES, stream);
    Params p{};
    const float** pp = (const float**)&p;
    for (int i = 0; i < 25; ++i) pp[i] = (const float*)d_in[i];
    p.out = (float*)d_out; p.ws = (unsigned char*)d_ws;
#if MEGA
    p.ph_lo = 0; p.ph_hi = NPH;
    void* args[] = {&p};
    hipError_t e = hipLaunchCooperativeKernel((const void*)fwd_kernel, dim3(grid), dim3(NT), args, LDS_BYTES, stream);
    if (e != hipSuccess) fprintf(stderr, "cooperative launch failed: %s (grid %d)\n", hipGetErrorString(e), grid);
#else
    for (int ph = 0; ph < NPH; ++ph) {
        p.ph_lo = ph; p.ph_hi = ph + 1;
        hipLaunchKernelGGL(fwd_kernel, dim3(grid), dim3(NT), LDS_BYTES, stream, p);
    }
#endif
}
```

```cpp
#include <hip/hip_runtime.h>
#include <hip/hip_cooperative_groups.h>
#include <cstdio>
#include <cstdint>
#include <type_traits>
namespace cg = cooperative_groups;

#ifndef MEGA
#define MEGA 1
#endif

#define LAS __attribute__((address_space(3)))
typedef unsigned short bf16_t;
typedef short bf16x8 __attribute__((ext_vector_type(8)));
typedef short s16x4 __attribute__((ext_vector_type(4)));
typedef float f32x4 __attribute__((ext_vector_type(4)));
typedef float f32x16 __attribute__((ext_vector_type(16)));
typedef unsigned u32x4 __attribute__((ext_vector_type(4)));
typedef unsigned u32x2 __attribute__((ext_vector_type(2)));

constexpr int NT = 512;
constexpr int DM = 1024, NBATCH = 8, SEQ = 2048, CTXL = 256, TPB = 2304, MROWS = NBATCH * TPB, DEPTH = 4, DIN = 5792, DFF = 2816;
constexpr int ZW = 2816, GW = 4096, GE = 512;
constexpr float EPS = 1e-6f;
constexpr float LOG2E = 1.4426950408889634f;
constexpr int Z_QA = 0, Z_KA = 256, Z_VA = 384, Z_QC = 512, Z_KC = 768, Z_VC = 896, Z_QBA = 1024, Z_KVBA = 1280, Z_KBR = 1408, Z_QBF = 1536, Z_KVBF = 1920, Z_UM = 2432;

constexpr size_t MiB = (size_t)1 << 20;
constexpr size_t WS_MODP = 0, WS_MOD = 7 * MiB, WS_ROPE = 7 * MiB + 917504, WS_BAR = WS_ROPE + 16384, BAR_BYTES = 16384;
constexpr size_t WS_W = 8 * MiB;
constexpr size_t WS_WCAT = WS_W, WS_WBT = WS_W + 27 * MiB / 2, WS_WO = WS_W + 31 * MiB / 2, WS_W13 = WS_W + 35 * MiB / 2, WS_W2 = WS_W + 57 * MiB / 2;
constexpr size_t WS_X = 42 * MiB, WS_H = 114 * MiB, WS_A = 150 * MiB, WS_B = 294 * MiB, WS_O = 366 * MiB, WS_GE = 402 * MiB, WS_END = 420 * MiB;
constexpr size_t AT_QA = 0, AT_KA = 9 * MiB, AT_VAT = 27 * MiB / 2, AT_QC = 18 * MiB, AT_KC = 27 * MiB, AT_VCT = 63 * MiB / 2, AT_QB = 36 * MiB, AT_KB = 99 * MiB / 2, AT_VBT = 63 * MiB;
constexpr int LDS_BYTES = 147456;
constexpr int MODSZ = DEPTH * 9 * 6144;

struct Params {
    const float *x, *c, *ctx, *c_ctx, *ada_w, *ada_b, *mix_pre_g, *mix_post_g, *ffn_pre_g, *ffn_post_g, *w_in, *a_qn_g, *a_kn_g, *b_qa_g, *b_kva_g,
        *b_w_qb, *b_w_kvb, *c_sink, *d_w_pool, *d_scale, *w_branch, *w_out, *w_ffn1, *w_ffn3, *w_ffn2;
    float* out; unsigned char* ws;
    int ph_lo, ph_hi;
};

typedef const __attribute__((address_space(4))) Params& CPARAMS;
__device__ __forceinline__ unsigned f2bf(float f) { unsigned u = __builtin_bit_cast(unsigned, f); return (u + 0x7fffu + ((u >> 16) & 1u)) >> 16; }
__device__ __forceinline__ unsigned pk2(float lo, float hi) { return f2bf(lo) | (f2bf(hi) << 16); }
__device__ __forceinline__ float bf2f(unsigned b) { return __builtin_bit_cast(float, b << 16); }
__device__ __forceinline__ float bflo(unsigned w) { return __builtin_bit_cast(float, w << 16); }
__device__ __forceinline__ float bfhi(unsigned w) { return __builtin_bit_cast(float, w & 0xffff0000u); }
__device__ __forceinline__ unsigned cvt_pk_bf16(float lo, float hi) { unsigned r; asm volatile("v_cvt_pk_bf16_f32 %0, %1, %2" : "=v"(r) : "v"(lo), "v"(hi)); return r; }
template <int N> __device__ __forceinline__ float row_ror(float v) { return __builtin_bit_cast(float, __builtin_amdgcn_update_dpp(0, __builtin_bit_cast(int, v), 0x120 + N, 0xf, 0xf, false)); }
__device__ __forceinline__ float row16_sum(float v) { v += row_ror<8>(v); v += row_ror<4>(v); v += row_ror<2>(v); v += row_ror<1>(v); return v; }
__device__ __forceinline__ void permlane32_swap_asm(unsigned& a, unsigned& b) { asm volatile("s_nop 1\n\tv_permlane32_swap_b32 %0, %1" : "+v"(a), "+v"(b)); }
__device__ __forceinline__ float xhalf_sum(float x) { unsigned a = __builtin_bit_cast(unsigned, x), b = a; permlane32_swap_asm(a, b); return __builtin_bit_cast(float, a) + __builtin_bit_cast(float, b); }
__device__ __forceinline__ float xhalf_max(float x) { unsigned a = __builtin_bit_cast(unsigned, x), b = a; permlane32_swap_asm(a, b); return fmaxf(__builtin_bit_cast(float, a), __builtin_bit_cast(float, b)); }
__device__ __forceinline__ float wave_sum(float v) {
    v = row16_sum(v);
    unsigned a = __builtin_bit_cast(unsigned, v), b = a;
    asm volatile("s_nop 1\n\tv_permlane16_swap_b32 %0, %1" : "+v"(a), "+v"(b));
    return xhalf_sum(__builtin_bit_cast(float, a) + __builtin_bit_cast(float, b));
}
__device__ __forceinline__ float fast_sigmoid(float x) { return __builtin_amdgcn_rcpf(1.0f + __builtin_amdgcn_exp2f(-x * LOG2E)); }
__device__ __forceinline__ int tid_l() { int t = threadIdx.x; asm volatile("" : "+v"(t)); return t; }
__device__ __forceinline__ int bid_l() { int b = blockIdx.x; asm volatile("" : "+s"(b)); return b; }
#define LDS_WAIT() asm volatile("s_waitcnt lgkmcnt(0)" ::: "memory")

namespace pg8 {
constexpr int BM = 256, BK = 64, HALF = 128, HTB = HALF * BK * 2, STAGE_BYTES = 8 * HTB, NXCD = 8, WGM = 8;
__host__ __device__ __forceinline__ int lds_byte(int r, int c) { const int st = (r >> 4) * 2 + (c >> 5), rr = r & 15, cc = c & 31, ob = rr * 64 + cc * 2; return st * 1024 + (ob ^ (((ob >> 9) & 1) << 5)); }
__host__ __device__ __forceinline__ void stage_rc(int b, int& R, int& C) { const int st = b / 1024, sb = b % 1024, swz = sb ^ (((sb >> 9) & 1) << 5); R = (st >> 1) * 16 + swz / 64; C = (st & 1) * 32 + (swz % 64) / 2; }
__host__ __device__ __forceinline__ int perm32(int rho) { const int n = rho >> 4, i = rho & 15; return 8 * (i >> 2) + 4 * n + (i & 3); }
struct Unit { int pm, pn, k0, nt, part; };
struct Gemm { const bf16_t* A; const bf16_t* Bt; int M, N, K; };
struct StaticOrder {
    int nM, nN, nwg, G, c, skip, split, ktot;
    __host__ __device__ void init(int M, int N, int K, int G_, int c_, int skip_ = 0, int split_ = 0) {
        skip = skip_ | split_; split = split_; ktot = K / BK; nM = skip ? 64 : M / BM; nN = N / BM; nwg = nM * nN + (split ? 8 * nN * 4 : 0); G = G_; c = c_; }
    __host__ __device__ bool next(int i, Unit& u) const {
        const long L = (long)i * G + c; if (L >= nwg) return false;
        const int nmain = nM * nN;
        const bool sub = L >= nmain;
        const int su = (int)L - nmain, cu = su >> 2, pt = su & 3;
        const int q = (ktot / 8) * 2, rem = ktot - 4 * q, nbig = rem / 2;
        int wgid = sub ? 0 : (int)L; { const int qq = nmain / NXCD, r = nmain % NXCD, xcd = wgid % NXCD, off = wgid / NXCD; wgid = (xcd < r ? xcd * (qq + 1) : r * (qq + 1) + (xcd - r) * qq) + off; }
        const int nig = WGM * nN, gid = wgid / nig, fm = gid * WGM, gsz = (nM - fm) < WGM ? (nM - fm) : WGM;
        int pm = fm + ((wgid % nig) % gsz); const int pn = (wgid % nig) / gsz; if (skip) pm = pm + pm / 8 + 1;
        u.pm = sub ? 9 * (cu / nN) : pm; u.pn = sub ? cu % nN : pn;
        u.k0 = sub ? pt * q + 2 * (pt < nbig ? pt : nbig) : 0; u.nt = sub ? q + (pt < nbig ? 2 : 0) : ktot; u.part = sub ? pt + 1 : 0;
        return true;
    }
    __device__ __forceinline__ void a_ready(const Unit&) const {}
    __device__ __forceinline__ void done(const Unit&) const {}
};

struct EpiP {
    static constexpr bool PERM = true, AFTER_DRAIN = false;
    bf16_t* O_; int ldc_; int mode_; int split_pn; bf16_t* O2; int ldc2; int mode2;
    bf16_t* Opart;
    __device__ __forceinline__ void operator()(const f32x4 (&acc)[2][2][4][2], const Unit& u, int wr, int wc, int fr, int fq) const {
        const bool hi = u.pn >= split_pn; bf16_t* O = hi ? O2 : O_; const int ldc = hi ? ldc2 : ldc_, mode = hi ? mode2 : mode_;
        if (u.part > 0) O = Opart + (size_t)(u.part - 1) * (2048 * 1024);
        const int row0 = (u.part > 0 ? (u.pm / 9) * BM : u.pm * BM) + wr * 64 + fr; const int col0 = (hi ? u.pn - split_pn : u.pn) * BM + wc * 32 + 8 * fq;
#pragma unroll
        for (int ai = 0; ai < 2; ++ai)
#pragma unroll
            for (int m = 0; m < 4; ++m) {
                const size_t row = (size_t)(row0 + ai * HALF + m * 16);
#pragma unroll
                for (int bj = 0; bj < 2; ++bj) {
                    f32x4 v0 = acc[ai][bj][m][0], v1 = acc[ai][bj][m][1]; const int c = col0 + bj * HALF;
                    if (mode == 2) {
                        const float o0 = v0[0] * fast_sigmoid(v0[0]) * v0[1], o1 = v0[2] * fast_sigmoid(v0[2]) * v0[3];
                        const float o2 = v1[0] * fast_sigmoid(v1[0]) * v1[1], o3 = v1[2] * fast_sigmoid(v1[2]) * v1[3];
                        u32x2 w; w.x = cvt_pk_bf16(o0, o1); w.y = cvt_pk_bf16(o2, o3);
                        *(u32x2*)(O + row * ldc + (c >> 1)) = w;
                    } else {
                        if (mode == 1) {
#pragma unroll
                            for (int e = 0; e < 4; ++e) { v0[e] = fast_sigmoid(v0[e]); v1[e] = fast_sigmoid(v1[e]); }
                        }
                        u32x4 w; w.x = cvt_pk_bf16(v0[0], v0[1]); w.y = cvt_pk_bf16(v0[2], v0[3]); w.z = cvt_pk_bf16(v1[0], v1[1]); w.w = cvt_pk_bf16(v1[2], v1[3]);
                        *(u32x4*)(O + row * ldc + c) = w;
                    }
                }
            }
    }
};
struct EpiF {
    static constexpr bool PERM = false, AFTER_DRAIN = false;
    float* O; int ldc;
    __device__ __forceinline__ void operator()(const f32x4 (&acc)[2][2][4][2], const Unit& u, int wr, int wc, int fr, int fq) const {
        const int row0 = u.pm * BM + wr * 64 + fr; const int col0 = u.pn * BM + wc * 32 + 4 * fq;
#pragma unroll
        for (int ai = 0; ai < 2; ++ai)
#pragma unroll
            for (int m = 0; m < 4; ++m) {
                float* rp = O + (size_t)(row0 + ai * HALF + m * 16) * ldc + col0;
#pragma unroll
                for (int bj = 0; bj < 2; ++bj)
#pragma unroll
                    for (int n = 0; n < 2; ++n) *(f32x4*)(rp + bj * HALF + n * 16) = acc[ai][bj][m][n];
            }
    }
};

template <class Epi, class Sched>
__device__ __forceinline__ void gemm_phase(LAS unsigned char* lds, const Gemm g, const Sched& S, const Epi& E) {
    const int tid = tid_l(), wid = __builtin_amdgcn_readfirstlane(tid >> 6), lane = tid & 63, wr = wid >> 2, wc = wid & 3, fr = lane & 15, fq = lane >> 4;
    const int K = g.K;
    unsigned voffA[2], voffB[2];
#pragma unroll
    for (int i = 0; i < 2; ++i) { int R, C; stage_rc(tid * 16 + i * 8192, R, C); const int Rb = Epi::PERM ? ((R & ~31) + perm32(R & 31)) : R;
        voffA[i] = (unsigned)(R * K + C) * 2u; voffB[i] = (unsigned)(Rb * K + C) * 2u; }
    const size_t kstep = (size_t)(BK * 2);
    const size_t hstep = (size_t)HALF * K * 2;
    const size_t tstep = 2 * hstep;
    const unsigned ldsw = (unsigned)wid * 1024u;
    const int aoff = lds_byte(wr * 64 + fr, fq * 8), boff = lds_byte(wc * 32 + fr, fq * 8);
#define PG8_SA(b, h) (((b) * 2 + (h)) * HTB)
#define PG8_SB(b, h) ((4 + (b) * 2 + (h)) * HTB)
#define PG8_STAGE(bufoff, gbase, voff) do { _Pragma("unroll") for (int _i = 0; _i < 2; ++_i) \
        __builtin_amdgcn_global_load_lds((const unsigned*)((const char*)(gbase) + (voff)[_i]), (LAS unsigned*)(lds + (bufoff) + ldsw + _i * 8192), 16, 0, 0); } while (0)
#define PG8_LDA(dst, b, h) do { _Pragma("unroll") for (int m = 0; m < 4; ++m) _Pragma("unroll") for (int k = 0; k < 2; ++k) dst[m][k] = *(const LAS bf16x8*)(lds + PG8_SA(b, h) + aoff + m * 2048 + k * 1024); } while (0)
#define PG8_LDB(dst, b, h) do { _Pragma("unroll") for (int n = 0; n < 2; ++n) _Pragma("unroll") for (int k = 0; k < 2; ++k) dst[n][k] = *(const LAS bf16x8*)(lds + PG8_SB(b, h) + boff + n * 2048 + k * 1024); } while (0)
#define PG8_MMA(ai, bj, At, Bt) do { __builtin_amdgcn_s_setprio(1); _Pragma("unroll") for (int m = 0; m < 4; ++m) _Pragma("unroll") for (int n = 0; n < 2; ++n) _Pragma("unroll") for (int k = 0; k < 2; ++k) \
        acc[ai][bj][m][n] = __builtin_amdgcn_mfma_f32_16x16x32_bf16(Bt[n][k], At[m][k], acc[ai][bj][m][n], 0, 0, 0); __builtin_amdgcn_s_setprio(0); } while (0)
#define PG8_WAIT_V(n) asm volatile("s_waitcnt vmcnt(" #n ")" ::: "memory")
#define PG8_WAIT_L(n) asm volatile("s_waitcnt lgkmcnt(" #n ")" ::: "memory")
#define PG8_BAR __builtin_amdgcn_s_barrier()
#define PG8_SCHED __builtin_amdgcn_sched_barrier(0)
    Unit cur, nxt; int ui = 0;
    if (!S.next(0, cur)) return;
    f32x4 acc[2][2][4][2];
#pragma unroll
    for (int a = 0; a < 2; ++a)
#pragma unroll
        for (int b = 0; b < 2; ++b)
#pragma unroll
            for (int m = 0; m < 4; ++m)
#pragma unroll
                for (int n = 0; n < 2; ++n) acc[a][b][m][n] = (f32x4){0.f, 0.f, 0.f, 0.f};
    bf16x8 At[4][2], B0[2][2], B1[2][2];
    const char* cA = (const char*)g.A + (size_t)cur.pm * tstep + (size_t)cur.k0 * kstep; const char* cB = (const char*)g.Bt + (size_t)cur.pn * tstep + (size_t)cur.k0 * kstep;
    PG8_STAGE(PG8_SB(0, 0), cB, voffB); PG8_STAGE(PG8_SB(0, 1), cB + hstep, voffB); PG8_STAGE(PG8_SA(0, 0), cA, voffA); PG8_STAGE(PG8_SA(0, 1), cA + hstep, voffA);
    if (wr == 1) PG8_BAR;
    PG8_WAIT_V(2); PG8_BAR;
    PG8_STAGE(PG8_SB(1, 0), cB + kstep, voffB); PG8_STAGE(PG8_SA(1, 0), cA + kstep, voffA); PG8_STAGE(PG8_SB(1, 1), cB + hstep + kstep, voffB);
    PG8_WAIT_V(6); PG8_BAR;
    for (;;) {
        const bool has_next = S.next(ui + 1, nxt);
        const char* nA = has_next ? (const char*)g.A + (size_t)nxt.pm * tstep + (size_t)nxt.k0 * kstep : cA; const char* nB = has_next ? (const char*)g.Bt + (size_t)nxt.pn * tstep + (size_t)nxt.k0 * kstep : cB;
        const int nt = cur.nt;
        for (int t = 0; t < nt; t += 2) {
            const bool last = (t == nt - 2);
            const char* a1 = cA + (size_t)(t + 1) * kstep;
            const char* a2 = last ? nA : cA + (size_t)(t + 2) * kstep; const char* b2 = last ? nB : cB + (size_t)(t + 2) * kstep;
            const char* a3 = a2 + kstep; const char* b3 = b2 + kstep;
            PG8_LDB(B0, 0, 0); PG8_LDB(B1, 0, 1); PG8_SCHED; PG8_LDA(At, 0, 0); PG8_STAGE(PG8_SA(1, 1), a1 + hstep, voffA);
            PG8_WAIT_V(8); PG8_WAIT_L(0); PG8_BAR; PG8_MMA(0, 0, At, B0); PG8_MMA(0, 1, At, B1); PG8_BAR; PG8_SCHED;
            PG8_LDA(At, 0, 1); PG8_STAGE(PG8_SB(0, 0), b2, voffB); PG8_STAGE(PG8_SB(0, 1), b2 + hstep, voffB); PG8_STAGE(PG8_SA(0, 0), a2, voffA);
            PG8_WAIT_V(8); PG8_WAIT_L(0); PG8_BAR; PG8_MMA(1, 0, At, B0); PG8_MMA(1, 1, At, B1); PG8_BAR; PG8_SCHED;
            PG8_LDB(B0, 1, 0); PG8_LDB(B1, 1, 1); PG8_SCHED; PG8_LDA(At, 1, 0); PG8_STAGE(PG8_SA(0, 1), a2 + hstep, voffA);
            PG8_WAIT_V(8); PG8_WAIT_L(0); PG8_BAR; PG8_MMA(0, 0, At, B0); PG8_MMA(0, 1, At, B1); PG8_BAR; PG8_SCHED;
            PG8_LDA(At, 1, 1); PG8_STAGE(PG8_SB(1, 0), b3, voffB); PG8_STAGE(PG8_SB(1, 1), b3 + hstep, voffB); PG8_STAGE(PG8_SA(1, 0), a3, voffA);
            PG8_WAIT_V(8); PG8_WAIT_L(0); PG8_BAR; PG8_MMA(1, 0, At, B0); PG8_MMA(1, 1, At, B1); PG8_BAR; PG8_SCHED;
        }
        if (wr == 0) PG8_BAR;
        E(acc, cur, wr, wc, fr, fq);
        if (!has_next) break;
#pragma unroll
        for (int a = 0; a < 2; ++a)
#pragma unroll
            for (int b = 0; b < 2; ++b)
#pragma unroll
                for (int m = 0; m < 4; ++m)
#pragma unroll
                    for (int n = 0; n < 2; ++n) acc[a][b][m][n] = (f32x4){0.f, 0.f, 0.f, 0.f};
        cur = nxt; cA = nA; cB = nB; ++ui;
        if (wr == 1) PG8_BAR;
    }
    PG8_WAIT_V(0);
    PG8_BAR;
#undef PG8_SA
#undef PG8_SB
#undef PG8_STAGE
#undef PG8_LDA
#undef PG8_LDB
#undef PG8_MMA
#undef PG8_WAIT_V
#undef PG8_WAIT_L
#undef PG8_BAR
#undef PG8_SCHED
}
}

__device__ __forceinline__ void mod_partial_phase(CPARAMS p, unsigned char* ws_, LAS unsigned char* lds) {
    LAS float* s = (LAS float*)lds;
    float* modp = (float*)(ws_ + WS_MODP);
    const int tid = tid_l();
    for (int it = bid_l(); it < 384; it += gridDim.x) {
        const int l = it / 96, r96 = it % 96, jb = r96 / 8, kc = r96 % 8;
        __syncthreads();
        for (int i = tid; i < 9 * 128; i += NT) { const int r9 = i >> 7, k = i & 127; const float v = r9 < 8 ? p.c[r9 * DM + kc * 128 + k] : p.c_ctx[kc * 128 + k]; s[i] = v / (1.0f + __expf(-v)); }
        __syncthreads();
        const int j = jb * 512 + tid;
        float a0 = 0.f, a1 = 0.f, a2 = 0.f, a3 = 0.f, a4 = 0.f, a5 = 0.f, a6 = 0.f, a7 = 0.f, a8 = 0.f;
        const float* w = p.ada_w + ((size_t)l * DM + kc * 128) * 6144 + j;
#pragma unroll 32
        for (int k = 0; k < 128; ++k) {
            const float wv = w[(size_t)k * 6144];
            a0 += s[k] * wv; a1 += s[128 + k] * wv; a2 += s[256 + k] * wv; a3 += s[384 + k] * wv; a4 += s[512 + k] * wv;
            a5 += s[640 + k] * wv; a6 += s[768 + k] * wv; a7 += s[896 + k] * wv; a8 += s[1024 + k] * wv;
        }
        float* o = modp + (size_t)kc * MODSZ + (size_t)l * 9 * 6144 + j;
        o[0] = a0; o[6144] = a1; o[2 * 6144] = a2; o[3 * 6144] = a3; o[4 * 6144] = a4; o[5 * 6144] = a5; o[6 * 6144] = a6; o[7 * 6144] = a7; o[8 * 6144] = a8;
    }
    __syncthreads();
}
__device__ __forceinline__ void rope_table_phase(CPARAMS p, unsigned char* ws_) {
    float* tab = (float*)(ws_ + WS_ROPE);
    for (int i = bid_l() * NT + tid_l(); i < 1024 + 512; i += gridDim.x * NT) {
        if (i < 1024) { const int pp = i >> 4, f = i & 15; const float inv = powf(10000.0f, -(float)f / 16.0f); const float a = (float)pp * inv; tab[i] = cosf(a); tab[1024 + i] = sinf(a); }
        else { const int q = i - 1024, pp = q >> 3, f = q & 7; const float inv = powf(10000.0f, -(float)f / 8.0f); const float a = (float)pp * inv; tab[2048 + q] = cosf(a); tab[2560 + q] = sinf(a); }
    }
}
__device__ __forceinline__ void mod_reduce_phase(CPARAMS p, unsigned char* ws_) {
    const float* modp = (const float*)(ws_ + WS_MODP); float* mod = (float*)(ws_ + WS_MOD);
    for (int i = bid_l() * NT + tid_l(); i < MODSZ; i += gridDim.x * NT) {
        const int l = i / (9 * 6144), j = i % 6144; float s = p.ada_b[l * 6144 + j];
#pragma unroll
        for (int kc = 0; kc < 8; ++kc) s += modp[(size_t)kc * MODSZ + i];
        mod[i] = s;
    }
}
__device__ __forceinline__ void tr_item(const float* W, int ldw, bf16_t* WT, int ldt, LAS float* scr, int lane, bool gperm = false, bool kperm = false) {
#pragma unroll
    for (int hf = 0; hf < 2; ++hf) {
        float tv[32];
#pragma unroll
        for (int i = 0; i < 32; ++i) tv[i] = W[(size_t)(hf * 32 + i) * ldw + lane];
        __builtin_amdgcn_sched_barrier(0);
#pragma unroll
        for (int i = 0; i < 32; ++i) scr[(hf * 32 + i) * 65 + lane] = tv[i];
    }
    LDS_WAIT(); asm volatile("" ::: "memory");
    const int c = lane & 7;
#pragma unroll
    for (int j = 0; j < 8; ++j) { const int n = (lane >> 3) + 8 * j; const LAS float* s = scr + (8 * c) * 65 + n;
        u32x4 o; o.x = pk2(s[0 * 65], s[1 * 65]); o.y = pk2(s[2 * 65], s[3 * 65]); o.z = pk2(s[4 * 65], s[5 * 65]); o.w = pk2(s[6 * 65], s[7 * 65]);
        const int nd = gperm ? ((n & 4) << 3) + ((n >> 3) << 2) + (n & 3) : n;
        if (kperm) { *(u32x2*)(WT + (size_t)nd * ldt + 4 * c) = (u32x2){o.x, o.y}; *(u32x2*)(WT + (size_t)nd * ldt + 32 + 4 * c) = (u32x2){o.z, o.w}; }
        else *(u32x4*)(WT + (size_t)nd * ldt + 8 * c) = o; }
    LDS_WAIT(); asm volatile("" ::: "memory");
}
#define TR_JOBP(Wp, ldw_, WTp, ldt_, K_, N_, GP_) { const int nblk = (N_) / 64; const int items = ((K_) / 64) * nblk; \
    if (r < items) { const int kb = r / nblk, nb = r % nblk; tr_item((Wp) + (size_t)(64 * kb) * (ldw_) + 64 * nb, (ldw_), (WTp) + (size_t)(64 * nb) * (ldt_) + 64 * kb, (ldt_), scr, lane, (GP_) == 1, (GP_) == 2 && kb < 12); continue; } r -= items; }
#define TR_JOB(Wp, ldw_, WTp, ldt_, K_, N_) TR_JOBP(Wp, ldw_, WTp, ldt_, K_, N_, 0)
__device__ __forceinline__ void prep_weights(CPARAMS p, unsigned char* ws_, int l, LAS unsigned char* lds, int mask, int widx, int nwork) {
    const int tid = tid_l(), lane = tid & 63, wave = __builtin_amdgcn_readfirstlane(tid >> 6);
    bf16_t* Wcat = (bf16_t*)(ws_ + WS_WCAT); bf16_t* Wbt = (bf16_t*)(ws_ + WS_WBT); bf16_t* Wo = (bf16_t*)(ws_ + WS_WO);
    bf16_t* W13 = (bf16_t*)(ws_ + WS_W13); bf16_t* W2 = (bf16_t*)(ws_ + WS_W2);
    const float* win = p.w_in + (size_t)l * DM * DIN;
    if (mask & 1) {
        LAS float* As = (LAS float*)lds;
        for (int it = widx; it < 288; it += nwork) {
            int type, jc, ib;
            if (it < 96) { type = 0; ib = it / 6; jc = it % 6; } else if (it < 224) { type = 1; ib = (it - 96) / 8; jc = (it - 96) % 8; } else { type = 2; ib = (it - 224) / 4; jc = (it - 224) % 4; }
            const int Kf = type == 0 ? 256 : (type == 1 ? 128 : 64);
            const int col0 = type == 0 ? 512 : (type == 1 ? 768 : 1440 + jc * 64);
            const float* gain = type == 0 ? p.b_qa_g + l * 256 : (type == 1 ? p.b_kva_g + l * 128 : nullptr);
            const int i0 = ib * 64, st = Kf + 1;
            const float* Wsm; int ldW, jbase, rowbase;
            if (type == 0) { Wsm = p.b_w_qb + (size_t)l * 256 * 384; ldW = 384; jbase = jc * 64; rowbase = Z_QBF; }
            else if (type == 1) { Wsm = p.b_w_kvb + (size_t)l * 128 * 512; ldW = 512; jbase = jc * 64; rowbase = Z_KVBF; }
            else { Wsm = p.d_w_pool + ((size_t)l * 4 + jc) * 64 * 64; ldW = 64; jbase = 0; rowbase = Z_UM + jc * 64; }
            LAS float* Ws = As + 64 * 257;
            __syncthreads();
            {
                const int lg = type == 0 ? 8 : (type == 1 ? 7 : 6), nit = (64 * Kf) / NT;
                for (int i0b = 0; i0b < nit; i0b += 8) {
                    float ta[8], tw[8], tg[8];
#pragma unroll
                    for (int q = 0; q < 8; ++q) { const int e = tid + (i0b + q) * NT, i = e >> lg, c = e & (Kf - 1);
                        ta[q] = win[(size_t)(i0 + i) * DIN + col0 + c]; tg[q] = gain ? gain[c] : 1.0f; tw[q] = Wsm[(size_t)(e >> 6) * ldW + jbase + (e & 63)]; }
                    __builtin_amdgcn_sched_barrier(0);
#pragma unroll
                    for (int q = 0; q < 8; ++q) { const int e = tid + (i0b + q) * NT, i = e >> lg, c = e & (Kf - 1); As[i * st + c] = ta[q] * tg[q]; Ws[e] = tw[q]; }
                }
            }
            __syncthreads();
            const int i = lane;
            float a0 = 0.f, a1 = 0.f, a2 = 0.f, a3 = 0.f, a4 = 0.f, a5 = 0.f, a6 = 0.f, a7 = 0.f;
            const LAS float* ap = As + i * st; const LAS float* wp = Ws + wave * 8;
#pragma unroll 4
            for (int c = 0; c < Kf; ++c) {
                const float a = ap[c]; const f32x4 w0 = *(const LAS f32x4*)(wp + c * 64), w1 = *(const LAS f32x4*)(wp + c * 64 + 4);
                a0 += a * w0.x; a1 += a * w0.y; a2 += a * w0.z; a3 += a * w0.w; a4 += a * w1.x; a5 += a * w1.y; a6 += a * w1.z; a7 += a * w1.w;
            }
            const int jl = wave * 8;
            if (type == 2) { const float* sc = p.d_scale + l * 256 + jc * 64 + jl; a0 *= sc[0]; a1 *= sc[1]; a2 *= sc[2]; a3 *= sc[3]; a4 *= sc[4]; a5 *= sc[5]; a6 *= sc[6]; a7 *= sc[7]; }
            bf16_t* wo = Wcat + (size_t)(rowbase + jbase + jl) * DM + i0 + i;
            wo[0] = (bf16_t)f2bf(a0); wo[DM] = (bf16_t)f2bf(a1); wo[2 * DM] = (bf16_t)f2bf(a2); wo[3 * DM] = (bf16_t)f2bf(a3);
            wo[4 * DM] = (bf16_t)f2bf(a4); wo[5 * DM] = (bf16_t)f2bf(a5); wo[6 * DM] = (bf16_t)f2bf(a6); wo[7 * DM] = (bf16_t)f2bf(a7);
        }
        __syncthreads();
    }
    LAS float* scr = (LAS float*)(lds + wave * 16640);
    const int gw = widx * 8 + wave, NGW = nwork * 8;
    constexpr int N0 = 128 + 128 + 96 + 16 + 1024, N2 = 704;
    if (mask & 1) for (int it = gw; it < N0; it += NGW) {
        int r = it;
        TR_JOB(win + 0, DIN, Wcat + (size_t)0 * DM, DM, 1024, 512)
        TR_JOB(win + 928, DIN, Wcat + (size_t)512 * DM, DM, 1024, 512)
        TR_JOB(win + 512, DIN, Wcat + (size_t)1024 * DM, DM, 1024, 384)
        TR_JOB(win + 896, DIN, Wcat + (size_t)1408 * DM, DM, 1024, 64)
        TR_JOBP(win + 1696, DIN, Wcat + (size_t)ZW * DM, DM, 1024, 4096, 1)
    }
    if (mask & 2) for (int it = gw; it < 512; it += NGW) {
        int r = it;
        TR_JOBP(p.w_branch + (size_t)l * 1024 * 1024, 1024, Wbt, 1024, 1024, 1024, 2)
        TR_JOB(p.w_out + (size_t)l * 1024 * 1024, 1024, Wo, 1024, 1024, 1024)
    }
    if (mask & 4) for (int it = gw; it < 1408; it += NGW) {
        int r = it;
        TR_JOB(p.w_ffn1 + (size_t)l * DM * DFF, DFF, W13, 2048, 1024, 2816)
        TR_JOB(p.w_ffn3 + (size_t)l * DM * DFF, DFF, W13 + 1024, 2048, 1024, 2816)
    }
    if (mask & 8) for (int it = gw; it < N2; it += NGW) {
        int r = it;
        TR_JOB(p.w_ffn2 + (size_t)l * DFF * DM, DM, W2, DFF, 2816, 1024)
    }
    __syncthreads();
}

template <int MODE, bool DRY = false>
__device__ __forceinline__ void row_phase(CPARAMS p, unsigned char* ws_, int l, int nsplit) {
    const int lane = tid_l() & 63, wave = tid_l() >> 6;
    const float* mod = (const float*)(ws_ + WS_MOD);
    bf16_t* xres = (bf16_t*)(ws_ + WS_X);
    const bf16_t* ybuf = (const bf16_t*)(ws_ + WS_B); bf16_t* hbuf = (bf16_t*)(ws_ + (DRY ? WS_O : WS_H));
    const int gw = bid_l() * 8 + wave, NGW = gridDim.x * 8;
    const int rpw = (MROWS + NGW - 1) / NGW;
    const bool fin = (MODE == 2 && l == DEPTH - 1);
    const int lh = MODE == 2 ? l + 1 : l;
    const float* gp = (MODE == 1 ? p.mix_post_g : p.ffn_post_g) + l * DM;
    const float* gpre = (MODE == 1 ? p.ffn_pre_g : p.mix_pre_g) + (fin ? 0 : lh) * DM;
    f32x4 gt[4], gg[4], gq[4], s1[4], s2[4];
#pragma unroll
    for (int j = 0; j < 4; ++j) { gg[j] = ((const f32x4*)gp)[lane + 64 * j]; gq[j] = ((const f32x4*)gpre)[lane + 64 * j]; gt[j] = gg[j]; s1[j] = gg[j]; s2[j] = gg[j]; }
    int cur_mrow = -1;
    auto load_params = [&](int mrow) {
        cur_mrow = mrow;
        const float* gate = mod + ((size_t)l * 9 + mrow) * 6144 + (MODE == 1 ? 2 : 5) * DM;
        const float* sh = mod + ((size_t)(fin ? 0 : lh) * 9 + mrow) * 6144 + (MODE == 1 ? 3 : 0) * DM;
        const float* sc = sh + DM;
#pragma unroll
        for (int j = 0; j < 4; ++j) { if (MODE >= 1) gt[j] = ((const f32x4*)gate)[lane + 64 * j]; s1[j] = ((const f32x4*)sh)[lane + 64 * j]; s2[j] = ((const f32x4*)sc)[lane + 64 * j]; }
    };
    auto finish_row = [&](int row, int b, int tau, f32x4 (&xv)[4], f32x4 (&yv)[4]) {
        if (MODE >= 1) {
            float ss = 0.f;
#pragma unroll
            for (int j = 0; j < 4; ++j) ss += (yv[j].x * yv[j].x + yv[j].y * yv[j].y) + (yv[j].z * yv[j].z + yv[j].w * yv[j].w);
            const float rstd = rsqrtf(wave_sum(ss) * (1.0f / DM) + EPS);
#pragma unroll
            for (int j = 0; j < 4; ++j) xv[j] = xv[j] + gt[j] * (yv[j] * rstd * gg[j]);
        }
        if (fin) {
            if (DRY) return;
            float* o = p.out + ((size_t)b * SEQ + (tau - CTXL)) * DM;
#pragma unroll
            for (int j = 0; j < 4; ++j) ((f32x4*)o)[lane + 64 * j] = xv[j];
            return;
        }
        if (!DRY) {
#pragma unroll
        for (int j = 0; j < 4; ++j) { u32x2 w; w.x = pk2(xv[j].x, xv[j].y); w.y = pk2(xv[j].z, xv[j].w); ((u32x2*)(xres + (size_t)row * DM))[lane + 64 * j] = w; }
        }
        float ss = 0.f;
#pragma unroll
        for (int j = 0; j < 4; ++j) ss += (xv[j].x * xv[j].x + xv[j].y * xv[j].y) + (xv[j].z * xv[j].z + xv[j].w * xv[j].w);
        const float rstd = rsqrtf(wave_sum(ss) * (1.0f / DM) + EPS);
#pragma unroll
        for (int j = 0; j < 4; ++j) {
            const f32x4 hv = (xv[j] * rstd * gq[j]) * (s2[j] + 1.0f) + s1[j];
            u32x2 w; w.x = pk2(hv.x, hv.y); w.y = pk2(hv.z, hv.w);
            ((u32x2*)(hbuf + (size_t)row * DM))[lane + 64 * j] = w;
        }
    };
    auto one_row = [&](int row) {
        const int b = row / TPB, tau = row % TPB, mrow = tau < CTXL ? 8 : b;
        if (MODE >= 1 && l == DEPTH - 1 && tau < CTXL) return;
        if (mrow != cur_mrow) load_params(mrow);
        const float* src = tau < CTXL ? p.ctx + ((size_t)b * CTXL + tau) * DM : p.x + ((size_t)b * SEQ + (tau - CTXL)) * DM;
        f32x4 xv[4], yv[4];
        if (MODE >= 1 && nsplit == 4 && tau < CTXL) {
            u32x2 xraw[4], yraw[4][4];
            const bf16_t* pp = (const bf16_t*)(ws_ + WS_O) + ((size_t)b * CTXL + tau) * DM;
#pragma unroll
            for (int j = 0; j < 4; ++j) { xraw[j] = ((const u32x2*)(xres + (size_t)row * DM))[lane + 64 * j];
#pragma unroll
                for (int q = 0; q < 4; ++q) yraw[j][q] = ((const u32x2*)(pp + (size_t)q * (2048 * 1024)))[lane + 64 * j]; }
            __builtin_amdgcn_sched_barrier(0);
#pragma unroll
            for (int j = 0; j < 4; ++j) {
                xv[j] = (f32x4){bflo(xraw[j].x), bfhi(xraw[j].x), bflo(xraw[j].y), bfhi(xraw[j].y)};
                yv[j] = (f32x4){bflo(yraw[j][0].x), bfhi(yraw[j][0].x), bflo(yraw[j][0].y), bfhi(yraw[j][0].y)};
#pragma unroll
                for (int q = 1; q < 4; ++q) yv[j] = yv[j] + (f32x4){bflo(yraw[j][q].x), bfhi(yraw[j][q].x), bflo(yraw[j][q].y), bfhi(yraw[j][q].y)};
            }
        } else {
            u32x2 xraw[4], yraw[4];
#pragma unroll
            for (int j = 0; j < 4; ++j) {
                if (MODE == 0) xv[j] = ((const f32x4*)src)[lane + 64 * j]; else xraw[j] = ((const u32x2*)(xres + (size_t)row * DM))[lane + 64 * j];
                if (MODE >= 1) yraw[j] = ((const u32x2*)(ybuf + (size_t)row * DM))[lane + 64 * j];
            }
            __builtin_amdgcn_sched_barrier(0);
            if (MODE >= 1) {
#pragma unroll
                for (int j = 0; j < 4; ++j) { xv[j] = (f32x4){bflo(xraw[j].x), bfhi(xraw[j].x), bflo(xraw[j].y), bfhi(xraw[j].y)}; yv[j] = (f32x4){bflo(yraw[j].x), bfhi(yraw[j].x), bflo(yraw[j].y), bfhi(yraw[j].y)}; }
            }
        }
        finish_row(row, b, tau, xv, yv);
    };
    for (int i = 0; i < rpw; i += 3) {
        const int row0 = gw * rpw + i; if (row0 >= MROWS) break;
        const int b0 = row0 / TPB, tau0 = row0 % TPB, mrow0 = tau0 < CTXL ? 8 : b0;
        const bool same = (i + 3 <= rpw) && (row0 + 2 < MROWS) && (MODE >= 1) && ((tau0 + 2) < TPB) && ((tau0 < CTXL) == ((tau0 + 2) < CTXL)) && !(tau0 < CTXL && (nsplit == 4 || l == DEPTH - 1));
        if (same) {
            if (mrow0 != cur_mrow) load_params(mrow0);
            u32x2 xr[3][4], yr[3][4];
#pragma unroll
            for (int q = 0; q < 3; ++q)
#pragma unroll
                for (int j = 0; j < 4; ++j) { xr[q][j] = ((const u32x2*)(xres + (size_t)(row0 + q) * DM))[lane + 64 * j]; yr[q][j] = ((const u32x2*)(ybuf + (size_t)(row0 + q) * DM))[lane + 64 * j]; }
            __builtin_amdgcn_sched_barrier(0);
#pragma unroll
            for (int q = 0; q < 3; ++q) {
                f32x4 xv[4], yv[4];
#pragma unroll
                for (int j = 0; j < 4; ++j) { xv[j] = (f32x4){bflo(xr[q][j].x), bfhi(xr[q][j].x), bflo(xr[q][j].y), bfhi(xr[q][j].y)}; yv[j] = (f32x4){bflo(yr[q][j].x), bfhi(yr[q][j].x), bflo(yr[q][j].y), bfhi(yr[q][j].y)}; }
                finish_row(row0 + q, b0, tau0 + q, xv, yv);
            }
        } else {
            for (int q = 0; q < 3; ++q) { if (i + q < rpw && row0 + q < MROWS) one_row(row0 + q); }
        }
    }
}

__device__ __forceinline__ void head64(const LAS bf16_t* zsrc, int nh, const LAS float* gain, bool rope, const LAS float* cs64, int prow, int pcol, float scale, bf16_t* dst, size_t head_stride, int lane) {
    const int hh = lane >> 4, q = lane & 15, hs = hh % nh;
    const unsigned a = *(const LAS unsigned*)(zsrc + hs * 64 + 2 * q), bb = *(const LAS unsigned*)(zsrc + hs * 64 + 32 + 2 * q);
    float x1a = bflo(a), x1b = bfhi(a), x2a = bflo(bb), x2b = bfhi(bb);
    if (gain) {
        float ss = (x1a * x1a + x1b * x1b) + (x2a * x2a + x2b * x2b);
        ss = row16_sum(ss);
        const float rstd = rsqrtf(ss * (1.0f / 64.0f) + EPS);
        x1a *= rstd * gain[2 * q]; x1b *= rstd * gain[2 * q + 1]; x2a *= rstd * gain[32 + 2 * q]; x2b *= rstd * gain[32 + 2 * q + 1];
    }
    if (rope) {
        const int pp = q < 8 ? prow : pcol, f = (2 * q) & 15;
        const float ca = cs64[pp * 16 + f], cb = cs64[pp * 16 + f + 1], sa = cs64[1024 + pp * 16 + f], sb = cs64[1024 + pp * 16 + f + 1];
        const float o1a = x1a * ca - x2a * sa, o2a = x1a * sa + x2a * ca, o1b = x1b * cb - x2b * sb, o2b = x1b * sb + x2b * cb;
        x1a = o1a; x2a = o2a; x1b = o1b; x2b = o2b;
    }
    if (hh < nh) {
        bf16_t* d = dst + (size_t)hh * head_stride;
        *(unsigned*)(d + 2 * q) = pk2(x1a * scale, x1b * scale);
        *(unsigned*)(d + 32 + 2 * q) = pk2(x2a * scale, x2b * scale);
    }
}
__device__ __forceinline__ void prep_phase(CPARAMS p, unsigned char* ws_, int l, LAS unsigned char* lds) {
    const int tid = tid_l(), lane = tid & 63, wave = tid >> 6;
    const bf16_t* z = (const bf16_t*)(ws_ + WS_A);
    unsigned char* at = ws_ + WS_B;
    bf16_t *Qa = (bf16_t*)(at + AT_QA), *Ka = (bf16_t*)(at + AT_KA), *VaT = (bf16_t*)(at + AT_VAT), *Qc = (bf16_t*)(at + AT_QC), *Kc = (bf16_t*)(at + AT_KC), *VcT = (bf16_t*)(at + AT_VCT);
    bf16_t *Qb = (bf16_t*)(at + AT_QB), *Kb = (bf16_t*)(at + AT_KB), *VbT = (bf16_t*)(at + AT_VBT);
    bf16_t* Ocat = (bf16_t*)(ws_ + WS_O);
    const float* tab = (const float*)(ws_ + WS_ROPE);
    LAS bf16_t* VT = (LAS bf16_t*)lds;
    LAS bf16_t* UM = VT + 512 * 40;
    LAS float* TAB = (LAS float*)(lds + 65536);
    LAS bf16_t* ZR = (LAS bf16_t*)(lds + 78336 + wave * 4864);
    const LAS float* cs64 = TAB; const LAS float* cs32 = TAB + 2048;
    const float scA = 0.125f * LOG2E, scB = 0.10206207261596575f * LOG2E;
    __syncthreads();
    { float tt[6];
#pragma unroll
      for (int q = 0; q < 6; ++q) tt[q] = tab[tid + q * NT];
      __builtin_amdgcn_sched_barrier(0);
#pragma unroll
      for (int q = 0; q < 6; ++q) TAB[tid + q * NT] = tt[q]; }
    if (tid < 64) { TAB[3072 + tid] = p.a_qn_g[l * 64 + tid]; TAB[3136 + tid] = p.a_kn_g[l * 64 + tid]; }
    __syncthreads();
    constexpr int TT = 24;
    for (int tile = bid_l(); tile < NBATCH * (TPB / TT); tile += gridDim.x) {
        const int b = tile / (TPB / TT), tau0 = (tile % (TPB / TT)) * TT;
        {
            u32x4 um[3];
#pragma unroll
            for (int q = 0; q < 3; ++q) { const int e = tid + q * NT, rr = e >> 5, part = e & 31; int tau = tau0 - 8 + rr; tau = tau < 0 ? 0 : (tau >= TPB ? TPB - 1 : tau);
                um[q] = *(const u32x4*)(z + ((size_t)b * TPB + tau) * ZW + Z_UM + part * 8); }
            __builtin_amdgcn_sched_barrier(0);
#pragma unroll
            for (int q = 0; q < 3; ++q) { const int e = tid + q * NT, rr = e >> 5, part = e & 31; if (e < (TT + 16) * 32) *(LAS u32x4*)(UM + rr * 256 + part * 8) = um[q]; }
        }
        u32x4 zreg[3][5];
#pragma unroll
        for (int q4 = 0; q4 < 3; ++q4) { const bf16_t* zg = z + ((size_t)b * TPB + tau0 + wave * 3 + q4) * ZW;
#pragma unroll
            for (int j = 0; j < 5; ++j) { const int ch = lane + 64 * j; if (ch < 304) zreg[q4][j] = *(const u32x4*)(zg + ch * 8); } }
#pragma unroll
        for (int q4 = 0; q4 < 3; ++q4) {
            const int tl = wave * 3 + q4, tau = tau0 + tl; const bool latent = tau >= CTXL;
#pragma unroll
            for (int j = 0; j < 5; ++j) { const int ch = lane + 64 * j; if (ch < 304) *(LAS u32x4*)(ZR + ch * 8) = zreg[q4][j]; }
            asm volatile("s_waitcnt lgkmcnt(0)" ::: "memory");
            const LAS bf16_t* zr = ZR;
            const int pos = latent ? tau - CTXL : 0, prow = pos >> 6, pcol = pos & 63;
            float sq = 0.f, skv = 0.f;
            { const u32x2 w = *(const LAS u32x2*)(zr + Z_QBA + 4 * lane); const float a0 = bflo(w.x), a1 = bfhi(w.x), a2 = bflo(w.y), a3 = bfhi(w.y); sq = (a0 * a0 + a1 * a1) + (a2 * a2 + a3 * a3);
              const unsigned v = *(const LAS unsigned*)(zr + Z_KVBA + 2 * lane); const float b0 = bflo(v), b1 = bfhi(v); skv = b0 * b0 + b1 * b1; }
            const float rq = rsqrtf(wave_sum(sq) * (1.0f / 256.0f) + EPS), rkv = rsqrtf(wave_sum(skv) * (1.0f / 128.0f) + EPS);
            head64(zr + Z_QA, 4, TAB + 3072, latent, cs64, prow, pcol, scA, Qa + ((size_t)(b * 4) * TPB + tau) * 64, (size_t)TPB * 64, lane);
            head64(zr + Z_KA, 2, TAB + 3136, latent, cs64, prow, pcol, 1.0f, Ka + ((size_t)(b * 2) * TPB + tau) * 64, (size_t)TPB * 64, lane);
            head64(zr + Z_QC, 4, nullptr, latent, cs64, prow, pcol, scA, Qc + ((size_t)(b * 4) * TPB + tau) * 64, (size_t)TPB * 64, lane);
            head64(zr + Z_KC, 2, nullptr, latent, cs64, prow, pcol, 1.0f, Kc + ((size_t)(b * 2) * TPB + tau) * 64, (size_t)TPB * 64, lane);
            {
                const int hh = lane >> 4, q = lane & 15;
                const int pp = q < 8 ? prow : pcol, f = q & 7;
                const float cc = latent ? cs32[pp * 8 + f] : 1.0f, sn = latent ? cs32[512 + pp * 8 + f] : 0.0f;
                bf16_t* qd = Qb + ((size_t)(b * 4 + hh) * TPB + tau) * 96; bf16_t* kd = Kb + ((size_t)(b * 4 + hh) * TPB + tau) * 96;
                { const u32x2 w = *(const LAS u32x2*)(zr + Z_QBF + hh * 96 + 4 * q); const float sN = rq * scB;
                  u32x2 o; o.x = pk2(bflo(w.x) * sN, bfhi(w.x) * sN); o.y = pk2(bflo(w.y) * sN, bfhi(w.y) * sN); *(u32x2*)(qd + 4 * q) = o;
                  const float x1 = bf2f(zr[Z_QBF + hh * 96 + 64 + q]) * sN, x2 = bf2f(zr[Z_QBF + hh * 96 + 80 + q]) * sN;
                  qd[64 + q] = (bf16_t)f2bf(x1 * cc - x2 * sn); qd[80 + q] = (bf16_t)f2bf(x1 * sn + x2 * cc); }
                { const u32x2 w = *(const LAS u32x2*)(zr + Z_KVBF + hh * 128 + 4 * q);
                  u32x2 o; o.x = pk2(bflo(w.x) * rkv, bfhi(w.x) * rkv); o.y = pk2(bflo(w.y) * rkv, bfhi(w.y) * rkv); *(u32x2*)(kd + 4 * q) = o;
                  const float x1 = bf2f(zr[Z_KBR + q]), x2 = bf2f(zr[Z_KBR + 16 + q]);
                  kd[64 + q] = (bf16_t)f2bf(x1 * cc - x2 * sn); kd[80 + q] = (bf16_t)f2bf(x1 * sn + x2 * cc); }
            }
#pragma unroll
            for (int j = 0; j < 2; ++j) { const int col = lane + 64 * j; VT[col * 40 + tl] = zr[Z_VA + col]; VT[(128 + col) * 40 + tl] = zr[Z_VC + col]; }
#pragma unroll
            for (int j = 0; j < 4; ++j) { const int ci = lane + 64 * j, hd = ci >> 6, dv = ci & 63; VT[(256 + ci) * 40 + tl] = (bf16_t)f2bf(bf2f(zr[Z_KVBF + hd * 128 + 64 + dv]) * rkv); }
            asm volatile("s_waitcnt lgkmcnt(0)" ::: "memory");
        }
        __syncthreads();
        {
            const int col = tid; bf16_t* dst;
            if (col < 128) dst = VaT + ((size_t)(b * 2 + (col >> 6)) * 64 + (col & 63)) * TPB + tau0;
            else if (col < 256) { const int c2 = col - 128; dst = VcT + ((size_t)(b * 2 + (c2 >> 6)) * 64 + (c2 & 63)) * TPB + tau0; }
            else { const int c2 = col - 256; dst = VbT + ((size_t)(b * 4 + (c2 >> 6)) * 64 + (c2 & 63)) * TPB + tau0; }
#pragma unroll
            for (int qd = 0; qd < 6; ++qd) { const int k = tau0 + 4 * qd, g = (k >> 2) & 3, pq = (g == 1) ? 2 : ((g == 2) ? 1 : g);
                *(u32x2*)(dst - tau0 + (k & ~15) + 4 * pq) = *(const LAS u32x2*)(VT + col * 40 + 4 * qd); }
        }
        {
            const int c = tid & 255, half = tid >> 8, g = c >> 6, win = 2 << g, lo = win >> 1, hi = win - lo - 1;
            for (int t = 0; t < TT / 2; ++t) {
                const int tau = tau0 + half * (TT / 2) + t;
                const int s0 = tau >= CTXL ? CTXL : 0, s1 = tau >= CTXL ? TPB : CTXL;
                const int st = max(tau - lo, s0), en = min(tau + hi + 1, s1);
                float sum = 0.f;
                for (int j = st; j < en; ++j) sum += bf2f(UM[(j - tau0 + 8) * 256 + c]);
                const float own = bf2f(UM[(tau - tau0 + 8) * 256 + c]);
                Ocat[((size_t)b * TPB + tau) * DM + 768 + c] = (bf16_t)f2bf(sum / (float)(en - st) - own);
            }
        }
        __syncthreads();
    }
}

struct AttnJob {
    const bf16_t* Q;
    const bf16_t* K;
    const bf16_t* VT;
    bf16_t* O;
    int nt0, t1lo, t1hi;
    int qtau0;
    int mask;
    float sink; int has_sink;
};
template <int DQK>
__device__ __forceinline__ void attn_unit(const AttnJob& J, LAS unsigned char* lds) {
    constexpr int KSTR = DQK + 8, VSTR = 72, NKK = DQK / 16;
    constexpr int KBYTES = 64 * KSTR * 2, VBYTES = 64 * VSTR * 2;
    constexpr int KCH = DQK / 8;
    const int tid = tid_l(), lane = tid & 63, r = lane & 31, h = lane >> 5;
    LAS unsigned char* Kbuf = lds; LAS unsigned char* Vbuf = lds + 2 * KBYTES;
    bf16x8 qf[NKK];
#pragma unroll
    for (int kk = 0; kk < NKK; ++kk) qf[kk] = *(const bf16x8*)(J.Q + (size_t)r * DQK + kk * 16 + h * 8);
    const int ntiles = J.nt0 + (J.t1hi - J.t1lo);
    const int k0key = tid / KCH, k0part = tid % KCH;
    const int k1 = tid + 512, k1key = k1 / KCH, k1part = k1 % KCH;
    const bool has_k1 = (DQK == 96) && (tid < 256);
    const int vdv = tid >> 3, vpart = tid & 7;
    u32x4 kx0, kx1 = (u32x4){0u, 0u, 0u, 0u}, vx, ky0, ky1 = (u32x4){0u, 0u, 0u, 0u}, vy;
    auto tile_of = [&](int i) { return i < J.nt0 ? i : J.t1lo + (i - J.nt0); };
    auto gloadK = [&](int ti, u32x4& r0, u32x4& r1) {
        const bf16_t* kp = J.K + (size_t)ti * 64 * DQK;
        r0 = *(const u32x4*)(kp + k0key * DQK + k0part * 8);
        if (has_k1) r1 = *(const u32x4*)(kp + k1key * DQK + k1part * 8);
    };
    auto gloadV = [&](int ti, u32x4& rv) { rv = *(const u32x4*)(J.VT + (size_t)vdv * TPB + ti * 64 + vpart * 8); };
    auto lstoreK = [&](int buf, const u32x4& r0, const u32x4& r1) {
        *(LAS u32x4*)(Kbuf + buf * KBYTES + (k0key * KSTR + k0part * 8) * 2) = r0;
        if (has_k1) *(LAS u32x4*)(Kbuf + buf * KBYTES + (k1key * KSTR + k1part * 8) * 2) = r1;
    };
    auto lstoreV = [&](int buf, const u32x4& rv) { *(LAS u32x4*)(Vbuf + buf * VBYTES + (vdv * VSTR + vpart * 8) * 2) = rv; };
    f32x16 negm;
#pragma unroll
    for (int i = 0; i < 16; ++i) negm[i] = 0.f;
    auto qk = [&](f32x16& x0, f32x16& x1, int slot) {
        const LAS unsigned char* Kb = Kbuf + slot * KBYTES;
        bf16x8 ka[NKK][2];
#pragma unroll
        for (int kk = 0; kk < NKK; ++kk) {
            ka[kk][0] = *(const LAS bf16x8*)(Kb + (r * KSTR + kk * 16 + h * 8) * 2);
            ka[kk][1] = *(const LAS bf16x8*)(Kb + ((32 + r) * KSTR + kk * 16 + h * 8) * 2);
        }
        __builtin_amdgcn_sched_barrier(0);
#pragma unroll
        for (int kk = 0; kk < NKK; ++kk) {
            if (kk == 0) { x0 = __builtin_amdgcn_mfma_f32_32x32x16_bf16(ka[kk][0], qf[kk], negm, 0, 0, 0); x1 = __builtin_amdgcn_mfma_f32_32x32x16_bf16(ka[kk][1], qf[kk], negm, 0, 0, 0); }
            else { x0 = __builtin_amdgcn_mfma_f32_32x32x16_bf16(ka[kk][0], qf[kk], x0, 0, 0, 0); x1 = __builtin_amdgcn_mfma_f32_32x32x16_bf16(ka[kk][1], qf[kk], x1, 0, 0, 0); }
        }
    };
    f32x16 o0, o1;
#pragma unroll
    for (int i = 0; i < 16; ++i) { o0[i] = 0.f; o1[i] = 0.f; }
    float lrun = 0.f;
    const int qtau = J.qtau0 + r;
    auto step = [&](int it, f32x16& sc0, f32x16& sc1, f32x16& sn0, f32x16& sn1, u32x4& lk0, u32x4& lk1, u32x4& lv, const u32x4& sk0, const u32x4& sk1, const u32x4& sv) {
        const bool more1 = it + 1 < ntiles, more2 = it + 2 < ntiles;
        if (it + 3 < ntiles) gloadK(tile_of(it + 3), lk0, lk1);
        if (more2) gloadV(tile_of(it + 2), lv);
        if (more1) qk(sn0, sn1, (it + 1) & 1);
        const int ti = tile_of(it);
        const LAS unsigned char* Vb = Vbuf + (it & 1) * VBYTES;
        u32x4 vf[4][2];
#pragma unroll
        for (int kq = 0; kq < 4; ++kq) {
            const int koff = (kq >> 1) * 32 + 16 * (kq & 1) + 8 * h;
            vf[kq][0] = *(const LAS u32x4*)(Vb + (r * VSTR + koff) * 2);
            vf[kq][1] = *(const LAS u32x4*)(Vb + ((32 + r) * VSTR + koff) * 2);
        }
        __builtin_amdgcn_sched_barrier(0);
        if (J.mask && it >= J.nt0) {
            const int kb0 = ti * 64 + 4 * h - qtau;
#pragma unroll
            for (int i = 0; i < 16; ++i) {
                const int d0 = kb0 + (i & 3) + 8 * (i >> 2), d1 = d0 + 32;
                if (d0 > 128 || d0 < -128) sc0[i] = -1e30f;
                if (d1 > 128 || d1 < -128) sc1[i] = -1e30f;
            }
        }
        float mx = sc0[0];
#pragma unroll
        for (int i = 1; i < 16; ++i) mx = fmaxf(mx, sc0[i]);
#pragma unroll
        for (int i = 0; i < 16; ++i) mx = fmaxf(mx, sc1[i]);
        mx = xhalf_max(mx);
        if (it == 0 || __any(mx > 8.0f)) {
            const float delta = (it == 0) ? mx : fmaxf(mx, 0.f);
            const float alpha = __builtin_amdgcn_exp2f(-delta);
            lrun *= alpha;
#pragma unroll
            for (int i = 0; i < 16; ++i) { o0[i] *= alpha; o1[i] *= alpha; sc0[i] -= delta; sc1[i] -= delta; negm[i] -= delta; }
            if (more1) {
#pragma unroll
                for (int i = 0; i < 16; ++i) { sn0[i] -= delta; sn1[i] -= delta; }
            }
        }
        float ls = 0.f;
#pragma unroll
        for (int i = 0; i < 16; ++i) { sc0[i] = __builtin_amdgcn_exp2f(sc0[i]); sc1[i] = __builtin_amdgcn_exp2f(sc1[i]); ls += sc0[i] + sc1[i]; }
        lrun += ls;
        bf16x8 pf[2][2];
#pragma unroll
        for (int sp = 0; sp < 2; ++sp) {
            u32x4 w0, w1;
            w0.x = cvt_pk_bf16(sc0[8 * sp + 0], sc0[8 * sp + 1]); w0.y = cvt_pk_bf16(sc0[8 * sp + 2], sc0[8 * sp + 3]); w0.z = cvt_pk_bf16(sc0[8 * sp + 4], sc0[8 * sp + 5]); w0.w = cvt_pk_bf16(sc0[8 * sp + 6], sc0[8 * sp + 7]);
            w1.x = cvt_pk_bf16(sc1[8 * sp + 0], sc1[8 * sp + 1]); w1.y = cvt_pk_bf16(sc1[8 * sp + 2], sc1[8 * sp + 3]); w1.z = cvt_pk_bf16(sc1[8 * sp + 4], sc1[8 * sp + 5]); w1.w = cvt_pk_bf16(sc1[8 * sp + 6], sc1[8 * sp + 7]);
            pf[0][sp] = __builtin_bit_cast(bf16x8, w0); pf[1][sp] = __builtin_bit_cast(bf16x8, w1);
        }
#pragma unroll
        for (int kb = 0; kb < 2; ++kb)
#pragma unroll
            for (int sp = 0; sp < 2; ++sp) {
                o0 = __builtin_amdgcn_mfma_f32_32x32x16_bf16(__builtin_bit_cast(bf16x8, vf[kb * 2 + sp][0]), pf[kb][sp], o0, 0, 0, 0);
                o1 = __builtin_amdgcn_mfma_f32_32x32x16_bf16(__builtin_bit_cast(bf16x8, vf[kb * 2 + sp][1]), pf[kb][sp], o1, 0, 0, 0);
            }
        if (more2) lstoreK(it & 1, sk0, sk1);
        if (more1) lstoreV((it + 1) & 1, sv);
        __syncthreads();
    };
    u32x4 kb0, kb1 = (u32x4){0u, 0u, 0u, 0u};
    gloadK(tile_of(0), kx0, kx1); gloadV(tile_of(0), vx); gloadK(tile_of(1), kb0, kb1);
    __syncthreads();
    lstoreK(0, kx0, kx1); lstoreV(0, vx); lstoreK(1, kb0, kb1);
    gloadK(tile_of(2), kx0, kx1); gloadV(tile_of(1), vx);
    __syncthreads();
    f32x16 sA0, sA1, sB0, sB1;
    qk(sA0, sA1, 0);
    __syncthreads();
#pragma unroll 1
    for (int it = 0; it < ntiles; it += 2) {
        step(it, sA0, sA1, sB0, sB1, ky0, ky1, vy, kx0, kx1, vx);
        if (it + 1 < ntiles) step(it + 1, sB0, sB1, sA0, sA1, kx0, kx1, vx, ky0, ky1, vy);
    }
    float ltot = xhalf_sum(lrun);
    if (J.has_sink) ltot += __builtin_amdgcn_exp2f(J.sink + negm[0]);
    const float inv = 1.0f / ltot;
    bf16_t* orow = J.O + (size_t)r * DM + 32 * h;
#pragma unroll
    for (int q = 0; q < 2; ++q) {
        u32x4 w; w.x = cvt_pk_bf16(o0[8 * q] * inv, o0[8 * q + 1] * inv); w.y = cvt_pk_bf16(o0[8 * q + 2] * inv, o0[8 * q + 3] * inv); w.z = cvt_pk_bf16(o0[8 * q + 4] * inv, o0[8 * q + 5] * inv); w.w = cvt_pk_bf16(o0[8 * q + 6] * inv, o0[8 * q + 7] * inv);
        ((u32x4*)orow)[q] = w;
        u32x4 w2; w2.x = cvt_pk_bf16(o1[8 * q] * inv, o1[8 * q + 1] * inv); w2.y = cvt_pk_bf16(o1[8 * q + 2] * inv, o1[8 * q + 3] * inv); w2.z = cvt_pk_bf16(o1[8 * q + 4] * inv, o1[8 * q + 5] * inv); w2.w = cvt_pk_bf16(o1[8 * q + 6] * inv, o1[8 * q + 7] * inv);
        ((u32x4*)orow)[2 + q] = w2;
    }
}
__device__ __forceinline__ void attn_phase(CPARAMS p, unsigned char* ws_, int l, LAS unsigned char* lds) {
    const int wave = __builtin_amdgcn_readfirstlane(tid_l() >> 6);
    unsigned char* at = ws_ + WS_B;
    const bf16_t *Qa = (const bf16_t*)(at + AT_QA), *Ka = (const bf16_t*)(at + AT_KA), *VaT = (const bf16_t*)(at + AT_VAT), *Qc = (const bf16_t*)(at + AT_QC), *Kc = (const bf16_t*)(at + AT_KC), *VcT = (const bf16_t*)(at + AT_VCT);
    const bf16_t *Qb = (const bf16_t*)(at + AT_QB), *Kb = (const bf16_t*)(at + AT_KB), *VbT = (const bf16_t*)(at + AT_VBT);
    bf16_t* Ocat = (bf16_t*)(ws_ + WS_O);
    const int G_ = gridDim.x, c_ = bid_l(), vcu = (G_ % 8 == 0) ? (c_ % 8) * (G_ / 8) + c_ / 8 : c_;
    for (int u = vcu; u < (l == DEPTH - 1 ? 768 : 864); u += G_) {
        AttnJob J; J.mask = 0; J.has_sink = 0; J.sink = 0.f; J.t1lo = 0; J.t1hi = 0;
        int kind, b, hk, qb, lat;
        if (u < 256) { kind = 0; lat = 1; b = u / 32; hk = (u % 32) / 16; qb = u % 16; }
        else if (u < 512) { const int v = u - 256; kind = 1; lat = 1; b = v / 32; hk = (v % 32) / 8; qb = v % 8; }
        else if (u < 768) { const int v = u - 512; kind = 2; lat = 1; b = v / 32; hk = (v % 32) / 16; qb = v % 16; }
        else if (u < 800) { const int v = u - 768; kind = 0; lat = 0; b = v / 4; hk = (v % 4) / 2; qb = v % 2; }
        else if (u < 832) { const int v = u - 800; kind = 1; lat = 0; b = v / 4; hk = v % 4; qb = 0; }
        else { const int v = u - 832; kind = 2; lat = 0; b = v / 4; hk = (v % 4) / 2; qb = v % 2; }
        J.nt0 = lat ? 36 : 4;
        if (kind == 1) {
            const int head = hk, tau0 = (lat ? CTXL : 0) + qb * 256 + wave * 32;
            J.Q = Qb + ((size_t)(b * 4 + head) * TPB + tau0) * 96; J.K = Kb + (size_t)(b * 4 + head) * TPB * 96; J.VT = VbT + (size_t)(b * 4 + head) * 64 * TPB;
            J.O = Ocat + ((size_t)b * TPB + tau0) * DM + 256 + head * 64; J.qtau0 = tau0;
            attn_unit<96>(J, lds);
        } else {
            const int head = hk * 2 + (wave >> 2), tau0 = (lat ? CTXL : 0) + qb * 128 + (wave & 3) * 32;
            const bf16_t *Qx = kind == 0 ? Qa : Qc, *Kx = kind == 0 ? Ka : Kc, *Vx = kind == 0 ? VaT : VcT;
            J.Q = Qx + ((size_t)(b * 4 + head) * TPB + tau0) * 64; J.K = Kx + (size_t)(b * 2 + hk) * TPB * 64; J.VT = Vx + (size_t)(b * 2 + hk) * 64 * TPB;
            J.O = Ocat + ((size_t)b * TPB + tau0) * DM + (kind == 0 ? 0 : 512) + head * 64; J.qtau0 = tau0;
            if (kind == 2) {
                J.has_sink = 1; J.sink = p.c_sink[l * 4 + head] * LOG2E;
                if (lat) { J.nt0 = 4; J.t1lo = max(2 * qb + 2, 4); J.t1hi = min(2 * qb + 8, 36); J.mask = 1; }
            }
            attn_unit<64>(J, lds);
        }
    }
    __syncthreads();
}

__device__ __forceinline__ void merge_phase(CPARAMS p, unsigned char* ws_, LAS unsigned char* lds, int skip) {
    constexpr int STR = 136;
    constexpr int TILEB = 128 * STR * 2, STAGEB = 2 * TILEB;
    const int tid = tid_l(), lane = tid & 63, wave = __builtin_amdgcn_readfirstlane(tid >> 6), r = lane & 31, h = lane >> 5;
    const int wt = wave & 3, wd = wave >> 2;
    const bf16_t* Ocat = (const bf16_t*)(ws_ + WS_O); const bf16_t* Wbt = (const bf16_t*)(ws_ + WS_WBT);
    const bf16_t* gates = (const bf16_t*)(ws_ + WS_A); const bf16_t* gearly = (const bf16_t*)(ws_ + WS_GE); bf16_t* merged = (bf16_t*)(ws_ + WS_H);
    const int G_ = gridDim.x, c_ = bid_l(), vcu = (G_ % 8 == 0) ? (c_ % 8) * (G_ / 8) + c_ / 8 : c_;
    const unsigned off0 = (unsigned)(((tid >> 4) * DM + (tid & 15) * 8) * 2);
    LAS unsigned char* ost = lds + ((tid >> 4) * STR + (tid & 15) * 8) * 2;
    for (int u = vcu; u < (skip ? 128 : 144) * 8; u += G_) {
        int tm = u >> 3; if (skip) tm = tm + (tm >> 4) * 2 + 2;
        const int tn = u & 7, t0 = tm * 128, d0 = tn * 128;
        f32x16 mg0, mg1, p0, p1;
#pragma unroll
        for (int i = 0; i < 16; ++i) { mg0[i] = 0.f; mg1[i] = 0.f; p0[i] = 0.f; p1[i] = 0.f; }
        const size_t trow = (size_t)(t0 + wt * 32 + r);
        const char* obase = (const char*)(Ocat + (size_t)t0 * DM); const char* wbase = (const char*)(Wbt + (size_t)d0 * DM);
        u32x4 ro[3][4], rw[3][4];
#define MERGE_LOADS(kc_) do { _Pragma("unroll") for (int e4 = 0; e4 < 4; ++e4) { \
            ro[(kc_) % 3][e4] = *(const u32x4*)(obase + (kc_) * 256 + (off0 + (unsigned)e4 * 65536u)); rw[(kc_) % 3][e4] = *(const u32x4*)(wbase + (kc_) * 256 + (off0 + (unsigned)e4 * 65536u)); } } while (0)
#define MERGE_STORES(kc_) do { _Pragma("unroll") for (int e4 = 0; e4 < 4; ++e4) { \
            *(LAS u32x4*)(ost + ((kc_) & 1) * STAGEB + e4 * (32 * STR * 2)) = ro[(kc_) % 3][e4]; *(LAS u32x4*)(ost + ((kc_) & 1) * STAGEB + TILEB + e4 * (32 * STR * 2)) = rw[(kc_) % 3][e4]; } } while (0)
        MERGE_LOADS(0); MERGE_LOADS(1); MERGE_LOADS(2);
        __syncthreads();
        MERGE_STORES(0);
        __syncthreads();
        u32x2 ga[4], gb[4];
#pragma unroll
        for (int kc = 0; kc < 8; ++kc) {
            const int kb = kc >> 1;
            if ((kc & 1) == 0) {
                const bf16_t* grow = (kb == 0 && d0 < GE) ? gearly + trow * GE + d0 + wd * 64 + 32 * h : gates + trow * GW + kb * 1024 + d0 + wd * 64 + 32 * h;
                { const u32x4 q0 = ((const u32x4*)grow)[0], q1 = ((const u32x4*)grow)[1], q2 = ((const u32x4*)grow)[2], q3 = ((const u32x4*)grow)[3];
                  ga[0] = (u32x2){q0.x, q0.y}; ga[1] = (u32x2){q0.z, q0.w}; ga[2] = (u32x2){q1.x, q1.y}; ga[3] = (u32x2){q1.z, q1.w};
                  gb[0] = (u32x2){q2.x, q2.y}; gb[1] = (u32x2){q2.z, q2.w}; gb[2] = (u32x2){q3.x, q3.y}; gb[3] = (u32x2){q3.z, q3.w}; }
            }
            if (kc + 1 < 8) MERGE_STORES(kc + 1);
            if (kc + 3 < 8) MERGE_LOADS(kc + 3);
            const LAS bf16_t* Ot = (const LAS bf16_t*)(lds + (kc & 1) * STAGEB); const LAS bf16_t* Wt = (const LAS bf16_t*)(lds + (kc & 1) * STAGEB + TILEB);
#pragma unroll
            for (int kh = 0; kh < 4; ++kh) {
                bf16x8 fb[2], fa0[2], fa1[2];
#pragma unroll
                for (int k4 = 0; k4 < 2; ++k4) {
                    const int ks = kh * 2 + k4;
                    fb[k4] = *(const LAS bf16x8*)(Ot + (wt * 32 + r) * STR + ks * 16 + h * 8);
                    fa0[k4] = *(const LAS bf16x8*)(Wt + (wd * 64 + r) * STR + ks * 16 + h * 8);
                    fa1[k4] = *(const LAS bf16x8*)(Wt + (wd * 64 + 32 + r) * STR + ks * 16 + h * 8);
                }
                __builtin_amdgcn_sched_barrier(0);
#pragma unroll
                for (int k4 = 0; k4 < 2; ++k4) {
                    p0 = __builtin_amdgcn_mfma_f32_32x32x16_bf16(fa0[k4], fb[k4], p0, 0, 0, 0);
                    p1 = __builtin_amdgcn_mfma_f32_32x32x16_bf16(fa1[k4], fb[k4], p1, 0, 0, 0);
                }
            }
            if (kc & 1) {
#pragma unroll
                for (int g = 0; g < 4; ++g) {
                    mg0[4 * g] += bflo(ga[g].x) * p0[4 * g]; mg0[4 * g + 1] += bfhi(ga[g].x) * p0[4 * g + 1]; mg0[4 * g + 2] += bflo(ga[g].y) * p0[4 * g + 2]; mg0[4 * g + 3] += bfhi(ga[g].y) * p0[4 * g + 3];
                    mg1[4 * g] += bflo(gb[g].x) * p1[4 * g]; mg1[4 * g + 1] += bfhi(gb[g].x) * p1[4 * g + 1]; mg1[4 * g + 2] += bflo(gb[g].y) * p1[4 * g + 2]; mg1[4 * g + 3] += bfhi(gb[g].y) * p1[4 * g + 3];
                }
#pragma unroll
                for (int i = 0; i < 16; ++i) { p0[i] = 0.f; p1[i] = 0.f; }
            }
            __syncthreads();
        }
#undef MERGE_LOADS
#undef MERGE_STORES
        bf16_t* mrow = merged + trow * DM + d0 + wd * 64 + 4 * h;
#pragma unroll
        for (int g = 0; g < 4; ++g) {
            u32x2 w; w.x = cvt_pk_bf16(mg0[4 * g], mg0[4 * g + 1]); w.y = cvt_pk_bf16(mg0[4 * g + 2], mg0[4 * g + 3]); *(u32x2*)(mrow + 8 * g) = w;
            u32x2 w2; w2.x = cvt_pk_bf16(mg1[4 * g], mg1[4 * g + 1]); w2.y = cvt_pk_bf16(mg1[4 * g + 2], mg1[4 * g + 3]); *(u32x2*)(mrow + 32 + 8 * g) = w2;
        }
    }
    __syncthreads();
}

#define XB_TMO      128
#define XB_XCNT(j)  (256  + 64 * (j))
#define XB_XSUB(j)  (1280 + 64 * (j))
#define XB_XGEN(j)  (2304 + 64 * (j))
#define XB_TOP      3328
#define XB_TOPGEN   3392
#define XCD_BAR_WORDS 3456
#define XB_SPIN_CAP (1u << 20)
__device__ __forceinline__ unsigned xb_ld(unsigned* p)              { return __hip_atomic_load(p, __ATOMIC_RELAXED, __HIP_MEMORY_SCOPE_AGENT); }
__device__ __forceinline__ unsigned xb_add(unsigned* p, unsigned v) { return __hip_atomic_fetch_add(p, v, __ATOMIC_RELAXED, __HIP_MEMORY_SCOPE_AGENT); }
__device__ __forceinline__ unsigned xb_xcc_id() { return (unsigned)__builtin_amdgcn_s_getreg((3 << 11) | 20) & 0xFu; }
#define XB_SPIN(cond, bar) do { unsigned _sp = 0; while (cond) { __builtin_amdgcn_s_sleep(1); \
    if ((++_sp & 255u) == 0u) { if (xb_ld(&(bar)[XB_TMO])) break; if (_sp > XB_SPIN_CAP) { atomicAdd(&(bar)[XB_TMO], 1u); break; } } } } while (0)
struct XcdBarrier { unsigned* bar; unsigned x; volatile LAS unsigned* st; };
__device__ __forceinline__ XcdBarrier xcd_barrier_post(unsigned* bar, volatile LAS unsigned* st) {
    XcdBarrier b; b.bar = bar; b.x = xb_xcc_id(); b.st = st;
    if (threadIdx.x == 0) (void)xb_add(&bar[XB_XCNT(b.x)], 1u);
    return b;
}
__device__ __forceinline__ void xcd_barrier_complete(unsigned* bar, unsigned x, unsigned& nloc, unsigned& nx) {
    const unsigned G = gridDim.x * gridDim.y * gridDim.z;
    unsigned sum, cnt, mine, sp = 0u;
    for (;;) {
        sum = 0u; cnt = 0u; mine = 0u;
#pragma unroll
        for (unsigned j = 0; j < 16; ++j) { const unsigned c = xb_ld(&bar[XB_XCNT(j)]); sum += c; cnt += (c > 0u) ? 1u : 0u; mine = (j == x) ? c : mine; }
        if (sum == G) break;
        __builtin_amdgcn_s_sleep(1);
        if ((++sp & 255u) == 0u) { if (xb_ld(&bar[XB_TMO])) break; if (sp > XB_SPIN_CAP) { atomicAdd(&bar[XB_TMO], 1u); break; } }
    }
    nloc = mine > 0u ? mine : 1u; nx = cnt > 0u ? cnt : 1u;
}
__device__ __forceinline__ void xcd_barrier(const XcdBarrier& b) {
    asm volatile("s_waitcnt vmcnt(0)" ::: "memory");
    __syncthreads();
    if (threadIdx.x == 0) {
        unsigned* bar = b.bar;
        __builtin_amdgcn_s_waitcnt(0);
        unsigned nloc = b.st[0], nx = b.st[1];
        if (nloc == 0u) { xcd_barrier_complete(bar, b.x, nloc, nx); b.st[0] = nloc; b.st[1] = nx; }
        const unsigned old = xb_add(&bar[XB_XSUB(b.x)], 1u);
        const unsigned gen = old / nloc;
        if (old + 1u == (gen + 1u) * nloc) {
            __builtin_amdgcn_fence(__ATOMIC_RELEASE, "agent");
            asm volatile("s_waitcnt vmcnt(0)" ::: "memory");
            const unsigned og = xb_add(&bar[XB_TOP], 1u);
            const unsigned tg = og / nx;
            if (og + 1u == (tg + 1u) * nx) xb_add(&bar[XB_TOPGEN], 1u);
            else XB_SPIN(xb_ld(&bar[XB_TOPGEN]) == tg, bar);
            __builtin_amdgcn_fence(__ATOMIC_ACQUIRE, "agent");
            xb_add(&bar[XB_XGEN(b.x)], 1u);
            asm volatile("s_waitcnt vmcnt(0)" ::: "memory");
        } else {
            XB_SPIN(xb_ld(&bar[XB_XGEN(b.x)]) == gen, bar);
            __builtin_amdgcn_fence(__ATOMIC_ACQUIRE, "agent");
            asm volatile("s_waitcnt vmcnt(0)" ::: "memory");
        }
    }
    __syncthreads();
}

constexpr int NPH = 3 + 9 * DEPTH;
__device__ __forceinline__ void run_phase(CPARAMS p, unsigned char* ws_, int ph, LAS unsigned char* lds) {
    const int G = gridDim.x, c = bid_l();
#ifndef ONLY
#define ONLY -1
#endif
#ifndef RP_ROW
#define RP_ROW 1
#endif
#ifndef RP_SYNC
#define RP_SYNC 1
#endif
#ifndef RP_P0
#define RP_P0 1
#endif
#ifndef RP_ATT
#define RP_ATT 1
#endif
#ifndef RP_GP
#define RP_GP 1
#endif
#ifndef RP_GF
#define RP_GF 1
#endif
#ifndef RP_PREP
#define RP_PREP 1
#endif
#ifndef RP_MERGE
#define RP_MERGE 1
#endif
#ifndef RP_PW
#define RP_PW 1
#endif
#ifndef ONLY2
#define ONLY2 -2
#endif
#ifndef ONLY3
#define ONLY3 -2
#endif
#define EN(id) (ONLY < 0 || ONLY == (id) || ONLY2 == (id) || ONLY3 == (id))
    if (ph == 0) { if (EN(100)) mod_partial_phase(p, ws_, lds); if (EN(101)) rope_table_phase(p, ws_); if (EN(102)) for (int rp = 0; rp < RP_PW; ++rp) prep_weights(p, ws_, 0, lds, 1 | 4, bid_l(), gridDim.x); return; }
    if (ph == 1) { if (EN(103)) mod_reduce_phase(p, ws_); return; }
    if (ph == 2) { if (EN(104)) row_phase<0>(p, ws_, 0, 0); return; }
    const int l = (ph - 3) / 9, s = (ph - 3) % 9;
    if (s == 1) { if (EN(1)) for (int rp = 0; rp < RP_PREP; ++rp) prep_phase(p, ws_, l, lds); return; }
    if (s == 3) { if (EN(3)) for (int rp = 0; rp < RP_MERGE; ++rp) merge_phase(p, ws_, lds, l == DEPTH - 1 ? 1 : 0); return; }
    if (s == 5) { if (EN(5)) row_phase<1>(p, ws_, l, (l < DEPTH - 1 && gridDim.x == 256) ? 4 : 0); return; }
    if (s == 8) { if (EN(8)) row_phase<2>(p, ws_, l, 0); return; }
    if (s == 2) { if (EN(2)) for (int rp = 0; rp < RP_ATT; ++rp) attn_phase(p, ws_, l, lds); }
    {
        if (EN(0)) {
        const bool n1k = (s == 4 || s == 7);
        const bf16_t* A = (const bf16_t*)(ws_ + (s == 7 ? WS_A : WS_H));
        const bf16_t* Bt = s == 4 ? (const bf16_t*)(ws_ + WS_WO) : s == 7 ? (const bf16_t*)(ws_ + WS_W2) : (const bf16_t*)(ws_ + (s == 6 ? WS_W13 : WS_WCAT)) + (s == 2 ? (size_t)(ZW + GE) * DM : (size_t)0);
        const int N = n1k ? DM : (s == 0 ? ZW + GE : (s == 2 ? GW - GE : 2 * DFF));
        const int K = s == 7 ? DFF : DM;
        const int split = (s == 4 && l < DEPTH - 1 && G == 256) ? 1 : 0;
        pg8::Gemm g{A, Bt, MROWS, N, K}; pg8::StaticOrder S; S.init(MROWS, N, K, G, c, (l == DEPTH - 1 && s != 0) ? 1 : 0, split);
        bf16_t* O = n1k ? (bf16_t*)(ws_ + WS_B) : (bf16_t*)(ws_ + WS_A) + (s == 2 ? GE : 0);
        const int ldc = n1k ? DM : (s == 0 ? ZW : (s == 2 ? GW : DFF));
        const int mode = n1k ? 0 : (s == 0 ? 0 : (s == 2 ? 1 : 2));
        pg8::EpiP E{O, ldc, mode, s == 0 ? ZW / 256 : 1 << 20, (bf16_t*)(ws_ + WS_GE), GE, 1, (bf16_t*)(ws_ + WS_O)};
        for (int rp = 0; rp < ((n1k ? RP_GF : RP_GP)); ++rp) pg8::gemm_phase<pg8::EpiP, pg8::StaticOrder>(lds, g, S, E);
        const int nfull = S.nwg % G;
        if (c >= nfull) {
            if (s == 0 && l == 0) for (int rp = 0; rp < RP_PW; ++rp) prep_weights(p, ws_, 0, lds, 2, c - nfull, G - nfull);
            if (s == 6) for (int rp = 0; rp < RP_PW; ++rp) prep_weights(p, ws_, l, lds, 8, c - nfull, G - nfull);
            if (s == 6 && l + 1 < DEPTH) for (int rp = 0; rp < RP_PW; ++rp) prep_weights(p, ws_, l + 1, lds, 2, c - nfull, G - nfull);
            if (s == 7 && l + 1 < DEPTH) for (int rp = 0; rp < RP_PW; ++rp) prep_weights(p, ws_, l + 1, lds, 1 | 4, c - nfull, G - nfull);
        }
        }
    }
}

__global__ void __launch_bounds__(NT, 2) fwd_kernel(Params p) {
    extern __shared__ __attribute__((aligned(16))) unsigned char lds_raw[];
    LAS unsigned char* lds = (LAS unsigned char*)lds_raw;
    volatile LAS unsigned* st = (volatile LAS unsigned*)(lds + LDS_BYTES - 64);
    if (threadIdx.x < 16) st[threadIdx.x] = 0u;
    __syncthreads();
    XcdBarrier gbar = xcd_barrier_post((unsigned*)(p.ws + WS_BAR), st);
    for (int rp0 = 1; rp0 < RP_P0; ++rp0) for (int ph = 0; ph < 3; ++ph) {
        const __attribute__((address_space(4))) char* ka0 = (const __attribute__((address_space(4))) char*)__builtin_amdgcn_kernarg_segment_ptr();
        asm volatile("" : "+s"(ka0));
        CPARAMS P0 = *(const __attribute__((address_space(4))) Params*)ka0;
        run_phase(P0, P0.ws, ph, lds);
        { XcdBarrier gb2 = gbar; asm volatile("" : "+s"(gb2.bar)); asm volatile("" : "+s"(gb2.x)); xcd_barrier(gb2); }
    }
    for (int ph = p.ph_lo; ph < p.ph_hi; ++ph) {
        const __attribute__((address_space(4))) char* ka = (const __attribute__((address_space(4))) char*)__builtin_amdgcn_kernarg_segment_ptr();
        asm volatile("" : "+s"(ka));
        CPARAMS P = *(const __attribute__((address_space(4))) Params*)ka;
        unsigned char* ws_ = P.ws;
        run_phase(P, ws_, ph, lds);
        if (ph + 1 < p.ph_hi) { if (p.ph_hi < 0) cg::this_grid().sync(); else for (int rs = 0; rs < RP_SYNC; ++rs) { XcdBarrier gb2 = gbar; asm volatile("" : "+s"(gb2.bar)); asm volatile("" : "+s"(gb2.x)); xcd_barrier(gb2); } }
    }
}

extern "C" void kernel_launch(void* const* d_in, const int* in_sizes, int n_in, void* d_out, int out_size, void* d_ws, size_t ws_size, hipStream_t stream) {
    static int grid = 0;
    if (grid == 0) {
        int dev = 0, cus = 0, per_cu = 0;
        hipGetDevice(&dev);
        hipDeviceGetAttribute(&cus, hipDeviceAttributeMultiprocessorCount, dev);
        hipFuncSetAttribute((const void*)fwd_kernel, hipFuncAttributeMaxDynamicSharedMemorySize, LDS_BYTES);
        hipOccupancyMaxActiveBlocksPerMultiprocessor(&per_cu, (const void*)fwd_kernel, NT, LDS_BYTES);
        if (per_cu < 1) { fprintf(stderr, "kernel_launch: occupancy query says %d blocks/CU\n", per_cu); per_cu = 1; }
        (void)hipGetLastError();
        grid = cus * per_cu;
        if (ws_size < WS_END) fprintf(stderr, "kernel_launch: workspace too small: %zu < %zu\n", ws_size, (size_t)WS_END);
    }
    (void)hipMemsetAsync((char*)d_ws + WS_BAR, 0, BAR_BYTES, stream);
    Params p{};
    const float** pp = (const float**)&p;
    for (int i = 0; i < 25; ++i) pp[i] = (const float*)d_in[i];
    p.out = (float*)d_out; p.ws = (unsigned char*)d_ws;
#if MEGA
    p.ph_lo = 0; p.ph_hi = NPH;
    void* args[] = {&p};
    hipError_t e = hipLaunchCooperativeKernel((const void*)fwd_kernel, dim3(grid), dim3(NT), args, LDS_BYTES, stream);
    if (e != hipSuccess) fprintf(stderr, "cooperative launch failed: %s (grid %d)\n", hipGetErrorString(e), grid);
#else
    for (int ph = 0; ph < NPH; ++ph) {
        p.ph_lo = ph; p.ph_hi = ph + 1;
        hipLaunchKernelGGL(fwd_kernel, dim3(grid), dim3(NT), LDS_BYTES, stream, p);
    }
#endif
}
```
